# Optimizing an MI355X kernel written in HIP

```python
import jax, jax.numpy as jnp
from jax import lax
import numpy as np

D_MODEL = 1024
BATCH = 8
SEQ = 4096
DEPTH = 1

GRID_W = 64
ROPE_THETA = 10000.0
Q_BLOCK = 128
EPS = 1e-6

MLA_HEADS = 8
MLA_NOPE = 64
MLA_ROPE = 32
MLA_QK = MLA_NOPE + MLA_ROPE
MLA_V = 64
Q_LORA = 768
KV_LORA = 256

GQA_HEADS = 8
GQA_KV_HEADS = 2
GQA_HEAD_DIM = 64

MLA_WIDTH = MLA_HEADS * MLA_V
GQA_WIDTH = GQA_HEADS * GQA_HEAD_DIM

SPLIT_SIZES = (
    Q_LORA,
    KV_LORA,
    MLA_ROPE,
    GQA_HEADS * GQA_HEAD_DIM,
    GQA_KV_HEADS * GQA_HEAD_DIM,
    GQA_KV_HEADS * GQA_HEAD_DIM,
    D_MODEL,
    D_MODEL,
)
IN_WIDTH = sum(SPLIT_SIZES)
SPLIT_POINTS = tuple(int(v) for v in np.cumsum(SPLIT_SIZES)[:-1])

N_EXPERTS = 16
CAPACITY_FACTOR = 2
EXPERT_FF = 1024

kernel_name = "hybrid_mla_gqa_axial_ec_moe_encoder"


def rmsnorm(x, g):
    xf = x.astype(jnp.float32)
    y = xf * lax.rsqrt(jnp.mean(xf * xf, axis=-1, keepdims=True) + EPS)
    return (y * g.astype(jnp.float32)).astype(x.dtype)


def axial_angles(n, rot_dim):
    rows = n // GRID_W
    row = jnp.broadcast_to(jnp.arange(rows)[:, None], (rows, GRID_W)).reshape(n).astype(jnp.float32)
    col = jnp.broadcast_to(jnp.arange(GRID_W)[None, :], (rows, GRID_W)).reshape(n).astype(jnp.float32)
    nf = rot_dim // 4
    inv = ROPE_THETA ** (-jnp.arange(nf, dtype=jnp.float32) / nf)
    ang = jnp.concatenate([row[:, None] * inv, col[:, None] * inv], axis=-1)
    return jnp.cos(ang), jnp.sin(ang)


def apply_rope(x, cos, sin):
    r = x.shape[-1]
    xf = x.astype(jnp.float32).reshape(*x.shape[:-1], r // 2, 2)
    x1, x2 = xf[..., 0], xf[..., 1]
    c = cos[None, :, None, :]
    s = sin[None, :, None, :]
    out = jnp.stack([x1 * c - x2 * s, x1 * s + x2 * c], axis=-1)
    return out.reshape(x.shape).astype(x.dtype)


def blocked_attention(q, k, v):
    b, s, h, d = q.shape
    kvh = k.shape[2]
    g = h // kvh
    dv = v.shape[-1]
    nb = s // Q_BLOCK
    scale = d ** -0.5
    qb = q.reshape(b, nb, Q_BLOCK, kvh, g, d).transpose(1, 0, 2, 3, 4, 5)

    def one_block(qblk):
        sc = jnp.einsum('bqkgd,bskd->bkgqs', qblk, k, preferred_element_type=jnp.float32) * scale
        p = jax.nn.softmax(sc, axis=-1).astype(v.dtype)
        return jnp.einsum('bkgqs,bskd->bqkgd', p, v)

    out = lax.map(one_block, qb)
    return out.transpose(1, 0, 2, 3, 4, 5).reshape(b, s, h, dv)


def ec_moe_sequence(h, w_router, b_router, w_exp_gate, w_exp_up, w_exp_down):
    s, d = h.shape
    cap = CAPACITY_FACTOR * s // N_EXPERTS
    logits = jnp.einsum('sd,de->se', h, w_router, preferred_element_type=jnp.float32) + b_router.astype(jnp.float32)
    aff = jax.nn.softmax(logits, axis=-1)
    gate, idx = lax.top_k(aff.T, cap)
    xe = h[idx]
    a = jnp.einsum('ecd,edf->ecf', xe, w_exp_gate)
    u = jnp.einsum('ecd,edf->ecf', xe, w_exp_up)
    y = jnp.einsum('ecf,efd->ecd', jax.nn.silu(a) * u, w_exp_down)
    y = y * gate[..., None].astype(y.dtype)
    return jnp.zeros((s, d), h.dtype).at[idx.reshape(-1)].add(y.reshape(-1, d))


def setup_inputs(seed: int = 0) -> dict:
    key = jax.random.key(seed)
    ks = jax.random.split(key, 24)
    f32 = jnp.float32

    def w(k, shape, fan_in):
        return jax.random.normal(k, shape, f32) * (fan_in ** -0.5)

    def gain(k, n):
        return 1.0 + 0.05 * jax.random.normal(k, (n,), f32)

    return {
        "x": jax.random.normal(ks[0], (BATCH, SEQ, D_MODEL), f32),
        "g_attn_norm": gain(ks[1], D_MODEL),
        "w_in": w(ks[2], (D_MODEL, IN_WIDTH), D_MODEL),
        "b_gate": 0.02 * jax.random.normal(ks[3], (2 * D_MODEL,), f32),
        "g_q_lat": gain(ks[4], Q_LORA),
        "w_q_up": w(ks[5], (Q_LORA, MLA_HEADS * MLA_QK), Q_LORA),
        "g_kv_lat": gain(ks[6], KV_LORA),
        "w_kv_up": w(ks[7], (KV_LORA, MLA_HEADS * (MLA_NOPE + MLA_V)), KV_LORA),
        "g_mla_qnorm": gain(ks[8], MLA_QK),
        "g_mla_knorm": gain(ks[9], MLA_QK),
        "g_gqa_qnorm": gain(ks[10], GQA_HEAD_DIM),
        "g_gqa_knorm": gain(ks[11], GQA_HEAD_DIM),
        "w_mla_branch": w(ks[12], (MLA_WIDTH, D_MODEL), MLA_WIDTH),
        "w_gqa_branch": w(ks[13], (GQA_WIDTH, D_MODEL), GQA_WIDTH),
        "w_out": w(ks[14], (D_MODEL, D_MODEL), D_MODEL),
        "g_ffn_norm": gain(ks[15], D_MODEL),
        "w_router": w(ks[16], (D_MODEL, N_EXPERTS), D_MODEL),
        "b_router": 0.01 * jax.random.normal(ks[17], (N_EXPERTS,), f32),
        "w_exp_gate": w(ks[18], (N_EXPERTS, D_MODEL, EXPERT_FF), D_MODEL),
        "w_exp_up": w(ks[19], (N_EXPERTS, D_MODEL, EXPERT_FF), D_MODEL),
        "w_exp_down": w(ks[20], (N_EXPERTS, EXPERT_FF, D_MODEL), EXPERT_FF),
    }


def reference(x, g_attn_norm, w_in, b_gate, g_q_lat, w_q_up, g_kv_lat, w_kv_up,
              g_mla_qnorm, g_mla_knorm, g_gqa_qnorm, g_gqa_knorm,
              w_mla_branch, w_gqa_branch, w_out, g_ffn_norm,
              w_router, b_router, w_exp_gate, w_exp_up, w_exp_down):
    b, s, _ = x.shape
    cos_mla, sin_mla = axial_angles(s, MLA_ROPE)
    cos_gqa, sin_gqa = axial_angles(s, GQA_HEAD_DIM)

    for _ in range(DEPTH):
        h = rmsnorm(x, g_attn_norm)
        proj = jnp.einsum('bsd,dn->bsn', h, w_in)
        q_lat, kv_lat, k_rope, q_g, k_g, v_g, gate_a, gate_b = jnp.split(proj, SPLIT_POINTS, axis=-1)

        c_q = rmsnorm(q_lat, g_q_lat)
        q_a = jnp.einsum('bsl,ln->bsn', c_q, w_q_up).reshape(b, s, MLA_HEADS, MLA_QK)
        c_kv = rmsnorm(kv_lat, g_kv_lat)
        kv_a = jnp.einsum('bsl,ln->bsn', c_kv, w_kv_up).reshape(b, s, MLA_HEADS, MLA_NOPE + MLA_V)
        k_nope, v_a = kv_a[..., :MLA_NOPE], kv_a[..., MLA_NOPE:]
        k_r = jnp.broadcast_to(k_rope[:, :, None, :], (b, s, MLA_HEADS, MLA_ROPE))
        k_a = jnp.concatenate([k_nope, k_r], axis=-1)
        q_a = rmsnorm(q_a, g_mla_qnorm)
        k_a = rmsnorm(k_a, g_mla_knorm)
        q_a = jnp.concatenate([q_a[..., :MLA_NOPE], apply_rope(q_a[..., MLA_NOPE:], cos_mla, sin_mla)], axis=-1)
        k_a = jnp.concatenate([k_a[..., :MLA_NOPE], apply_rope(k_a[..., MLA_NOPE:], cos_mla, sin_mla)], axis=-1)
        y_a = blocked_attention(q_a, k_a, v_a).reshape(b, s, MLA_WIDTH)

        q_b = rmsnorm(q_g.reshape(b, s, GQA_HEADS, GQA_HEAD_DIM), g_gqa_qnorm)
        k_b = rmsnorm(k_g.reshape(b, s, GQA_KV_HEADS, GQA_HEAD_DIM), g_gqa_knorm)
        v_b = v_g.reshape(b, s, GQA_KV_HEADS, GQA_HEAD_DIM)
        q_b = apply_rope(q_b, cos_gqa, sin_gqa)
        k_b = apply_rope(k_b, cos_gqa, sin_gqa)
        y_b = blocked_attention(q_b, k_b, v_b).reshape(b, s, GQA_WIDTH)

        ga = jax.nn.sigmoid(gate_a + b_gate[:D_MODEL])
        gb = jax.nn.sigmoid(gate_b + b_gate[D_MODEL:])
        merged = (ga * jnp.einsum('bsm,md->bsd', y_a, w_mla_branch)
                  + gb * jnp.einsum('bsm,md->bsd', y_b, w_gqa_branch))
        x = x + jnp.einsum('bsd,de->bse', merged, w_out)

        h2 = rmsnorm(x, g_ffn_norm)
        moe = jax.vmap(ec_moe_sequence, in_axes=(0, None, None, None, None, None))(
            h2, w_router, b_router, w_exp_gate, w_exp_up, w_exp_down)
        x = x + moe
    return x
```

```cpp
#include <hip/hip_runtime.h>
#include <hip/hip_bf16.h>
#include <hip/hip_cooperative_groups.h>
#include <cstdio>
#include <cstdint>
namespace cg = cooperative_groups;

#ifndef MK_CG
#define MK_CG 0
#endif
#ifndef PROBE_PH
#define PROBE_PH -1
#define PROBE_REPS 1
#endif
#define REPS(k) for (int rp_ = 0; rp_ < ((k) == PROBE_PH ? PROBE_REPS : 1); ++rp_)
#ifndef MK_MULTI
#define MK_MULTI 0
#endif

constexpr int BATCH = 8, SEQ = 4096, DM = 1024, T = BATCH * SEQ;
constexpr int QL = 768, KVL = 256, LATW = 1056;
constexpr int NEXP = 16, CAP = 512, FF = 1024;
constexpr float EPS = 1e-6f;
constexpr int NPH = 13;

#define LAS __attribute__((address_space(3)))
#define GAS __attribute__((address_space(1)))
typedef unsigned short bf16_t;
typedef short bf16x8 __attribute__((ext_vector_type(8)));
typedef float f32x4 __attribute__((ext_vector_type(4)));
typedef float f32x2 __attribute__((ext_vector_type(2)));
typedef float f32x16 __attribute__((ext_vector_type(16)));
typedef unsigned u32x4 __attribute__((ext_vector_type(4)));
typedef unsigned u32x2 __attribute__((ext_vector_type(2)));
typedef short s16x4 __attribute__((ext_vector_type(4)));

__device__ __forceinline__ unsigned cvt_pk_bf16(float lo, float hi) { unsigned r; asm volatile("v_cvt_pk_bf16_f32 %0, %1, %2" : "=v"(r) : "v"(lo), "v"(hi)); return r; }
__device__ __forceinline__ u32x4 pack8(f32x4 a, f32x4 b) { u32x4 w; w.x = cvt_pk_bf16(a[0], a[1]); w.y = cvt_pk_bf16(a[2], a[3]); w.z = cvt_pk_bf16(b[0], b[1]); w.w = cvt_pk_bf16(b[2], b[3]); return w; }
__device__ __forceinline__ float bf_lo(unsigned w) { return __uint_as_float(w << 16); }
__device__ __forceinline__ float bf_hi(unsigned w) { return __uint_as_float(w & 0xffff0000u); }
__device__ __forceinline__ void unpack8(u32x4 w, f32x4& a, f32x4& b) { a[0] = bf_lo(w.x); a[1] = bf_hi(w.x); a[2] = bf_lo(w.y); a[3] = bf_hi(w.y); b[0] = bf_lo(w.z); b[1] = bf_hi(w.z); b[2] = bf_lo(w.w); b[3] = bf_hi(w.w); }
__device__ __forceinline__ u32x2 pack8_fp8(f32x4 a, f32x4 b) { u32x2 w; int t = __builtin_amdgcn_cvt_pk_fp8_f32(a[0], a[1], 0, false); t = __builtin_amdgcn_cvt_pk_fp8_f32(a[2], a[3], t, true); w.x = (unsigned)t;
    t = __builtin_amdgcn_cvt_pk_fp8_f32(b[0], b[1], 0, false); t = __builtin_amdgcn_cvt_pk_fp8_f32(b[2], b[3], t, true); w.y = (unsigned)t; return w; }
__device__ __forceinline__ void unpack8_fp8(u32x2 w, f32x4& a, f32x4& b) {
    const f32x2 p0 = __builtin_amdgcn_cvt_pk_f32_fp8((int)w.x, false), p1 = __builtin_amdgcn_cvt_pk_f32_fp8((int)w.x, true), p2 = __builtin_amdgcn_cvt_pk_f32_fp8((int)w.y, false), p3 = __builtin_amdgcn_cvt_pk_f32_fp8((int)w.y, true);
    a[0] = p0[0]; a[1] = p0[1]; a[2] = p1[0]; a[3] = p1[1]; b[0] = p2[0]; b[1] = p2[1]; b[2] = p3[0]; b[3] = p3[1]; }
__device__ __forceinline__ int vt_pos(int s) { const int k = s & 15; return (s & ~15) | (((k >> 2) & 1) << 3) | ((k >> 3) << 2) | (k & 3); }
__device__ __forceinline__ void store_vt(bf16_t* vt, int d0, int s, f32x4 a0, f32x4 a1, f32x4 c0, f32x4 c1) {
    bf16_t* p = vt + (size_t)d0 * SEQ + vt_pos(s);
    const u32x4 wa = pack8(a0, a1), wc = pack8(c0, c1);
    p[0 * SEQ] = (bf16_t)(wa.x & 0xffffu); p[1 * SEQ] = (bf16_t)(wa.x >> 16); p[2 * SEQ] = (bf16_t)(wa.y & 0xffffu); p[3 * SEQ] = (bf16_t)(wa.y >> 16);
    p[4 * SEQ] = (bf16_t)(wa.z & 0xffffu); p[5 * SEQ] = (bf16_t)(wa.z >> 16); p[6 * SEQ] = (bf16_t)(wa.w & 0xffffu); p[7 * SEQ] = (bf16_t)(wa.w >> 16);
    p += (size_t)32 * SEQ;
    p[0 * SEQ] = (bf16_t)(wc.x & 0xffffu); p[1 * SEQ] = (bf16_t)(wc.x >> 16); p[2 * SEQ] = (bf16_t)(wc.y & 0xffffu); p[3 * SEQ] = (bf16_t)(wc.y >> 16);
    p[4 * SEQ] = (bf16_t)(wc.z & 0xffffu); p[5 * SEQ] = (bf16_t)(wc.z >> 16); p[6 * SEQ] = (bf16_t)(wc.w & 0xffffu); p[7 * SEQ] = (bf16_t)(wc.w >> 16);
}
typedef _Float16 h16x8 __attribute__((ext_vector_type(8)));
typedef float f32x8v __attribute__((ext_vector_type(8)));
__device__ __forceinline__ u32x4 pack8_f16(f32x4 a, f32x4 b) { const f32x8v v = {a[0], a[1], a[2], a[3], b[0], b[1], b[2], b[3]}; return __builtin_bit_cast(u32x4, __builtin_convertvector(v, h16x8)); }
__device__ __forceinline__ void unpack8_f16(u32x4 w, f32x4& a, f32x4& b) { const f32x8v v = __builtin_convertvector(__builtin_bit_cast(h16x8, w), f32x8v); a = (f32x4){v[0], v[1], v[2], v[3]}; b = (f32x4){v[4], v[5], v[6], v[7]}; }
__device__ __forceinline__ float sigmoidf_(float x) { return __builtin_amdgcn_rcpf(1.f + __builtin_amdgcn_exp2f(-1.4426950408889634f * x)); }

__device__ __forceinline__ void rope_cs(float pos, int fi, float nf_inv, float& s, float& c) {
    const float inv = __builtin_amdgcn_exp2f(-(float)fi * nf_inv * 13.287712379549449f);
    const float rev = pos * inv * 0.15915494309189535f; const float fr = rev - floorf(rev);
    s = __builtin_amdgcn_sinf(fr); c = __builtin_amdgcn_cosf(fr);
}
__device__ __forceinline__ f32x4 rope4t(f32x4 v, f32x4 cs) {
    f32x4 r; r[0] = v[0] * cs[0] - v[1] * cs[1]; r[1] = v[0] * cs[1] + v[1] * cs[0]; r[2] = v[2] * cs[2] - v[3] * cs[3]; r[3] = v[2] * cs[3] + v[3] * cs[2]; return r;
}
__device__ __forceinline__ f32x4 rope4(f32x4 v, float pos, int f0, float nf_inv) {
    float s0, c0, s1, c1; rope_cs(pos, f0, nf_inv, s0, c0); rope_cs(pos, f0 + 1, nf_inv, s1, c1);
    f32x4 r; r[0] = v[0] * c0 - v[1] * s0; r[1] = v[0] * s0 + v[1] * c0; r[2] = v[2] * c1 - v[3] * s1; r[3] = v[2] * s1 + v[3] * c1; return r;
}

namespace pg8 {
constexpr int BM = 256, BK = 64, HALF = 128, HTB = HALF * BK * 2, STAGE_BYTES = 8 * HTB, NXCD = 8, WGM = 8;
__host__ __device__ __forceinline__ int lds_byte(int r, int c) { const int st = (r >> 4) * 2 + (c >> 5), rr = r & 15, cc = c & 31, ob = rr * 64 + cc * 2; return st * 1024 + (ob ^ (((ob >> 9) & 1) << 5)); }
__host__ __device__ __forceinline__ void stage_rc(int b, int& R, int& C) { const int st = b / 1024, sb = b % 1024, swz = sb ^ (((sb >> 9) & 1) << 5); R = (st >> 1) * 16 + swz / 64; C = (st & 1) * 32 + (swz % 64) / 2; }
__host__ __device__ __forceinline__ int perm32(int rho) { const int n = rho >> 4, i = rho & 15; return 8 * (i >> 2) + 4 * n + (i & 3); }

struct Unit { int pm, pn, pb; };
struct Gemm { const bf16_t* A; const bf16_t* Bt; const int* rowmap; };

template <int M, int N, int BDIV> struct TileOrder {
    static constexpr int nM = M / BM, nN = N / BM, nwg = nM * nN;
    int G, c;
    __device__ __forceinline__ void init(int G_, int c_) { G = G_; c = c_; }
    __device__ __forceinline__ bool next(int i, Unit& u) const {
        const int L = i * G + c; if (L >= nwg) return false;
        int wgid = L; { constexpr int q = nwg / NXCD, r = nwg % NXCD; const int xcd = wgid % NXCD, off = wgid / NXCD; wgid = (xcd < r ? xcd * (q + 1) : r * (q + 1) + (xcd - r) * q) + off; }
        constexpr int nig = WGM * nN; const int gid = wgid / nig, fm = gid * WGM, gsz = (nM - fm) < WGM ? (nM - fm) : WGM;
        u.pm = fm + ((wgid % nig) % gsz); u.pn = (wgid % nig) / gsz; u.pb = (BDIV ? (u.pm / (BDIV ? BDIV : 1)) * nN : 0) + u.pn; return true;
    }
};

typedef int v4i_t __attribute__((ext_vector_type(4)));
typedef int v8i_t __attribute__((ext_vector_type(8)));
template <int K, int LDA, bool GATHER = false, int ES = 2, class Epi, class Sched>
__device__ __forceinline__ void gemm_phase(LAS unsigned char* lds, const Gemm g, const Sched& S, const Epi& E) {
    int tid = threadIdx.x; asm volatile("" : "+v"(tid));
    const int wid = __builtin_amdgcn_readfirstlane(tid >> 6), lane = tid & 63, wr = wid >> 2, wc = wid & 3, fr = lane & 15, fq = lane >> 4;
    constexpr int nt = K * ES / (BK * 2), lda = LDA; static_assert((K * ES) % 256 == 0 && K * ES >= 512, "K bytes: multiple of 256, >= 512");
    unsigned voffA[2], voffB[2]; int gR[2]; unsigned gC[2];
#pragma unroll
    for (int i = 0; i < 2; ++i) { int R, C; stage_rc(tid * 16 + i * 8192, R, C); const int Rb = (R & ~31) + perm32(R & 31);
        voffA[i] = (unsigned)(R * lda * ES + C * 2); voffB[i] = (unsigned)(Rb * K * ES + C * 2); gR[i] = R; gC[i] = (unsigned)C * 2u; }
    unsigned cof[2][2], nof[2][2];
#define PG8_GOFF(dst, pm_) do { _Pragma("unroll") for (int h_ = 0; h_ < 2; ++h_) _Pragma("unroll") for (int i_ = 0; i_ < 2; ++i_) \
        dst[h_][i_] = (unsigned)g.rowmap[(pm_) * BM + h_ * HALF + gR[i_]] * (unsigned)(lda * ES) + gC[i_]; } while (0)
    constexpr size_t kstep = (size_t)(BK * 2);
    constexpr size_t hstepA = (size_t)HALF * lda * ES, hstepB = (size_t)HALF * K * ES;
    constexpr size_t tstepA = 2 * hstepA, tstepB = 2 * hstepB;
    const unsigned ldsw = (unsigned)wid * 1024u;
    const int aoff = lds_byte(wr * 64 + fr, fq * 8), boff = lds_byte(wc * 32 + fr, fq * 8);
#define PG8_SA(b, h) (((b) * 2 + (h)) * HTB)
#define PG8_SB(b, h) ((4 + (b) * 2 + (h)) * HTB)
#define PG8_STAGE(bufoff, gbase, voff) do { _Pragma("unroll") for (int _i = 0; _i < 2; ++_i) \
        __builtin_amdgcn_global_load_lds((const unsigned*)((const char*)(gbase) + (voff)[_i]), (LAS unsigned*)(lds + (bufoff) + ldsw + _i * 8192), 16, 0, 0); } while (0)
#define PG8_STAGE1(bufoff, gbase, voff0, rowbytes) do { _Pragma("unroll") for (int _i = 0; _i < 2; ++_i) \
        __builtin_amdgcn_global_load_lds((const unsigned*)((const char*)(gbase) + (size_t)_i * 64 * (rowbytes) + (voff0)), (LAS unsigned*)(lds + (bufoff) + ldsw + _i * 8192), 16, 0, 0); } while (0)
#define PG8_LDA(dst, b, h) do { _Pragma("unroll") for (int m = 0; m < 4; ++m) { \
        if constexpr (ES == 2) { _Pragma("unroll") for (int k = 0; k < 2; ++k) dst[m][k] = *(const LAS bf16x8*)(lds + PG8_SA(b, h) + aoff + m * 2048 + k * 1024); } \
        else { dst##8[m] = __builtin_shufflevector(*(const LAS v4i_t*)(lds + PG8_SA(b, h) + aoff + m * 2048), *(const LAS v4i_t*)(lds + PG8_SA(b, h) + aoff + m * 2048 + 1024), 0, 1, 2, 3, 4, 5, 6, 7); } } } while (0)
#define PG8_LDB(dst, b, h) do { _Pragma("unroll") for (int n = 0; n < 2; ++n) { \
        if constexpr (ES == 2) { _Pragma("unroll") for (int k = 0; k < 2; ++k) dst[n][k] = *(const LAS bf16x8*)(lds + PG8_SB(b, h) + boff + n * 2048 + k * 1024); } \
        else { dst##8[n] = __builtin_shufflevector(*(const LAS v4i_t*)(lds + PG8_SB(b, h) + boff + n * 2048), *(const LAS v4i_t*)(lds + PG8_SB(b, h) + boff + n * 2048 + 1024), 0, 1, 2, 3, 4, 5, 6, 7); } } } while (0)
#define PG8_MMA(ai, bj, At, Bt) do { __builtin_amdgcn_s_setprio(1); _Pragma("unroll") for (int m = 0; m < 4; ++m) _Pragma("unroll") for (int n = 0; n < 2; ++n) { \
        if constexpr (ES == 2) { _Pragma("unroll") for (int k = 0; k < 2; ++k) acc[ai][bj][m][n] = __builtin_amdgcn_mfma_f32_16x16x32_bf16(Bt[n][k], At[m][k], acc[ai][bj][m][n], 0, 0, 0); } \
        else { asm volatile("v_mfma_scale_f32_16x16x128_f8f6f4 %0, %1, %2, %0, %3, %3 op_sel_hi:[0,0,0]" : "+v"(acc[ai][bj][m][n]) : "v"(Bt##8[n]), "v"(At##8[m]), "v"(one_scale)); } } \
        __builtin_amdgcn_s_setprio(0); } while (0)
#define PG8_WAIT_V(n) asm volatile("s_waitcnt vmcnt(" #n ")" ::: "memory")
#define PG8_WAIT_L(n) asm volatile("s_waitcnt lgkmcnt(" #n ")" ::: "memory")
#define PG8_BAR __builtin_amdgcn_s_barrier()
#define PG8_SCHED __builtin_amdgcn_sched_barrier(0)
    Unit cur, nxt; int ui = 0;
    if (!S.next(0, cur)) return;
    f32x4 acc[2][2][4][2];
#pragma unroll
    for (int a = 0; a < 2; ++a)
#pragma unroll
        for (int b = 0; b < 2; ++b)
#pragma unroll
            for (int m = 0; m < 4; ++m)
#pragma unroll
                for (int n = 0; n < 2; ++n) acc[a][b][m][n] = (f32x4){0.f, 0.f, 0.f, 0.f};
    bf16x8 At[4][2], B0[2][2], B1[2][2]; v8i_t At8[4], B08[2], B18[2];
    const int one_scale = 0x7f7f7f7f;
    const char* cA = GATHER ? (const char*)g.A : (const char*)g.A + (size_t)cur.pm * tstepA; const char* cB = (const char*)g.Bt + (size_t)cur.pb * tstepB;
    if constexpr (GATHER) { PG8_GOFF(cof, cur.pm); }
    PG8_STAGE1(PG8_SB(0, 0), cB, voffB[0], K * ES); PG8_STAGE1(PG8_SB(0, 1), cB + hstepB, voffB[0], K * ES);
    if constexpr (GATHER) { PG8_STAGE(PG8_SA(0, 0), cA, cof[0]); PG8_STAGE(PG8_SA(0, 1), cA, cof[1]); } else { PG8_STAGE1(PG8_SA(0, 0), cA, voffA[0], lda * ES); PG8_STAGE1(PG8_SA(0, 1), cA + hstepA, voffA[0], lda * ES); }
    if (wr == 1) PG8_BAR;
    PG8_WAIT_V(2); PG8_BAR;
    PG8_STAGE1(PG8_SB(1, 0), cB + kstep, voffB[0], K * ES);
    if constexpr (GATHER) { PG8_STAGE(PG8_SA(1, 0), cA + kstep, cof[0]); } else { PG8_STAGE1(PG8_SA(1, 0), cA + kstep, voffA[0], lda * ES); }
    PG8_STAGE1(PG8_SB(1, 1), cB + hstepB + kstep, voffB[0], K * ES);
    PG8_WAIT_V(6); PG8_BAR;
    for (;;) {
        const bool has_next = S.next(ui + 1, nxt);
        const char* nA = GATHER ? cA : (has_next ? (const char*)g.A + (size_t)nxt.pm * tstepA : cA); const char* nB = has_next ? (const char*)g.Bt + (size_t)nxt.pb * tstepB : cB;
        if constexpr (GATHER) { if (has_next) { PG8_GOFF(nof, nxt.pm); } else {
#pragma unroll
            for (int h_ = 0; h_ < 2; ++h_) { nof[h_][0] = cof[h_][0]; nof[h_][1] = cof[h_][1]; } } }
#pragma unroll 1
        for (int t = 0; t < nt; t += 2) {
            const bool last = (t == nt - 2);
            const char* a1 = cA + (size_t)(t + 1) * kstep;
            const char* a2 = last ? nA : cA + (size_t)(t + 2) * kstep; const char* b2 = last ? nB : cB + (size_t)(t + 2) * kstep;
            const char* a3 = a2 + kstep; const char* b3 = b2 + kstep;
            unsigned sel0[2], sel1[2];
            if constexpr (GATHER) { sel0[0] = last ? nof[0][0] : cof[0][0]; sel0[1] = last ? nof[0][1] : cof[0][1]; sel1[0] = last ? nof[1][0] : cof[1][0]; sel1[1] = last ? nof[1][1] : cof[1][1]; }
            PG8_LDB(B0, 0, 0); PG8_LDB(B1, 0, 1); PG8_SCHED; PG8_LDA(At, 0, 0);
            if constexpr (GATHER) { PG8_STAGE(PG8_SA(1, 1), a1, cof[1]); } else { PG8_STAGE1(PG8_SA(1, 1), a1 + hstepA, voffA[0], lda * ES); }
            PG8_WAIT_V(8); PG8_WAIT_L(0); PG8_BAR; PG8_MMA(0, 0, At, B0); PG8_MMA(0, 1, At, B1); PG8_BAR; PG8_SCHED;
            PG8_LDA(At, 0, 1); PG8_STAGE1(PG8_SB(0, 0), b2, voffB[0], K * ES); PG8_STAGE1(PG8_SB(0, 1), b2 + hstepB, voffB[0], K * ES);
            if constexpr (GATHER) { PG8_STAGE(PG8_SA(0, 0), a2, sel0); } else { PG8_STAGE1(PG8_SA(0, 0), a2, voffA[0], lda * ES); }
            PG8_WAIT_V(8); PG8_WAIT_L(0); PG8_BAR; PG8_MMA(1, 0, At, B0); PG8_MMA(1, 1, At, B1); PG8_BAR; PG8_SCHED;
            PG8_LDB(B0, 1, 0); PG8_LDB(B1, 1, 1); PG8_SCHED; PG8_LDA(At, 1, 0);
            if constexpr (GATHER) { PG8_STAGE(PG8_SA(0, 1), a2, sel1); } else { PG8_STAGE1(PG8_SA(0, 1), a2 + hstepA, voffA[0], lda * ES); }
            PG8_WAIT_V(8); PG8_WAIT_L(0); PG8_BAR; PG8_MMA(0, 0, At, B0); PG8_MMA(0, 1, At, B1); PG8_BAR; PG8_SCHED;
            PG8_LDA(At, 1, 1); PG8_STAGE1(PG8_SB(1, 0), b3, voffB[0], K * ES); PG8_STAGE1(PG8_SB(1, 1), b3 + hstepB, voffB[0], K * ES);
            if constexpr (GATHER) { PG8_STAGE(PG8_SA(1, 0), a3, sel0); } else { PG8_STAGE1(PG8_SA(1, 0), a3, voffA[0], lda * ES); }
            PG8_WAIT_V(8); PG8_WAIT_L(0); PG8_BAR; PG8_MMA(1, 0, At, B0); PG8_MMA(1, 1, At, B1); PG8_BAR; PG8_SCHED;
            if constexpr (Epi::MIDT > 0) { if (t + 2 == Epi::MIDT) { if constexpr (ES == 1) asm volatile("s_nop 15\n\ts_nop 15" ::: "memory"); E.mid(acc, cur, wr, wc, fr, fq); if constexpr (ES == 1) asm volatile("s_nop 7" ::: "memory"); } }
        }
        if (wr == 0) PG8_BAR;
        if constexpr (ES == 1) asm volatile("s_nop 15\n\ts_nop 15" ::: "memory");
        E(acc, cur, wr, wc, fr, fq);
        if (!has_next) break;
#pragma unroll
        for (int a = 0; a < 2; ++a)
#pragma unroll
            for (int b = 0; b < 2; ++b)
#pragma unroll
                for (int m = 0; m < 4; ++m)
#pragma unroll
                    for (int n = 0; n < 2; ++n) acc[a][b][m][n] = (f32x4){0.f, 0.f, 0.f, 0.f};
        cur = nxt; cA = nA; cB = nB; ++ui;
        if constexpr (GATHER) {
#pragma unroll
            for (int h_ = 0; h_ < 2; ++h_) { cof[h_][0] = nof[h_][0]; cof[h_][1] = nof[h_][1]; } }
        if (wr == 1) PG8_BAR;
    }
    PG8_WAIT_V(0);
    PG8_BAR;
#undef PG8_GOFF
#undef PG8_SA
#undef PG8_SB
#undef PG8_STAGE
#undef PG8_STAGE1
#undef PG8_LDA
#undef PG8_LDB
#undef PG8_MMA
#undef PG8_WAIT_V
#undef PG8_WAIT_L
#undef PG8_BAR
#undef PG8_SCHED
}

#define EPI_ROWS_BEGIN  _Pragma("unroll") for (int ai = 0; ai < 2; ++ai) _Pragma("unroll") for (int m = 0; m < 4; ++m) { const int row = u.pm * BM + ai * HALF + wr * 64 + m * 16 + fr;
#define EPI_ROWS_END    if (m & 1) asm volatile("" ::: "memory"); }
#define EPI_ROWS_END4   if (m == 3) asm volatile("" ::: "memory"); }
#define EPI_COL(bj) ((bj) * HALF + wc * 32 + fq * 8)

struct EpiProj {
    static constexpr int MIDT = 0;
    const float* rinv1; bf16_t* LAT; float* SSQ; bf16_t* Qb; bf16_t* Kb; bf16_t* Vb; unsigned char* GATES; const float* b_gate; const float* gk; const float* T16;
    __device__ __forceinline__ void operator()(const f32x4 (&acc)[2][2][4][2], const Unit& u, int wr, int wc, int fr, int fq) const {
        const int pn = u.pn;
        if (pn >= 8) {
            f32x4 bv[2][2];
#pragma unroll
            for (int bj = 0; bj < 2; ++bj) { const int gc = (pn - 8) * BM + EPI_COL(bj); bv[bj][0] = *(const f32x4*)(b_gate + gc) * -1.4426950408889634f; bv[bj][1] = *(const f32x4*)(b_gate + gc + 4) * -1.4426950408889634f; }
            EPI_ROWS_BEGIN
                const float ri = rinv1[row] * (0.03125f * -1.4426950408889634f);
#pragma unroll
                for (int bj = 0; bj < 2; ++bj) { const int gc = (pn - 8) * BM + EPI_COL(bj);
                    f32x4 v0 = acc[ai][bj][m][0] * ri + bv[bj][0], v1 = acc[ai][bj][m][1] * ri + bv[bj][1];
#pragma unroll
                    for (int j = 0; j < 4; ++j) { v0[j] = __builtin_amdgcn_rcpf(fmaf(__builtin_amdgcn_exp2f(v0[j]), 0.00390625f, 0.00390625f)); v1[j] = __builtin_amdgcn_rcpf(fmaf(__builtin_amdgcn_exp2f(v1[j]), 0.00390625f, 0.00390625f)); }
                    *(u32x2*)(GATES + (size_t)row * 2048 + gc) = pack8_fp8(v0, v1); }
            EPI_ROWS_END
        } else if (pn < 4) {
            EPI_ROWS_BEGIN
                const float ri = rinv1[row] * 0.03125f; float ss = 0.f;
#pragma unroll
                for (int bj = 0; bj < 2; ++bj) { const f32x4 v0 = acc[ai][bj][m][0] * ri, v1 = acc[ai][bj][m][1] * ri;
                    ss += (v0[0] * v0[0] + v0[1] * v0[1]) + (v0[2] * v0[2] + v0[3] * v0[3]) + (v1[0] * v1[0] + v1[1] * v1[1]) + (v1[2] * v1[2] + v1[3] * v1[3]);
                    *(u32x4*)(LAT + (size_t)row * LATW + pn * BM + EPI_COL(bj)) = pack8(v0, v1); }
                ss += __shfl_xor(ss, 16); ss += __shfl_xor(ss, 32);
                if (fq == 0) SSQ[(size_t)row * 16 + pn * 4 + wc] = ss;
            EPI_ROWS_END
        } else if (pn == 4) {
            if (wc == 0) {
                EPI_ROWS_BEGIN
                    const float ri = rinv1[row] * 0.03125f;
                    *(u32x4*)(LAT + (size_t)row * LATW + 1024 + fq * 8) = pack8(acc[ai][0][m][0] * ri, acc[ai][0][m][1] * ri);
                EPI_ROWS_END
            }
        } else if (pn < 7) {
            EPI_ROWS_BEGIN
                const float ri = rinv1[row] * 0.03125f; const int b = row >> 12, s = row & 4095;
#pragma unroll
                for (int bj = 0; bj < 2; ++bj) { const int col = EPI_COL(bj), head = (pn - 5) * 4 + (col >> 6), d = col & 63;
                    *(u32x4*)(Qb + ((size_t)(b * 8 + head) * SEQ + s) * 64 + d) = pack8(acc[ai][bj][m][0] * ri, acc[ai][bj][m][1] * ri); }
            EPI_ROWS_END
        } else {
            if (wc < 2) {
                const f32x4 g00 = *(const f32x4*)(gk + 8 * fq), g01 = *(const f32x4*)(gk + 8 * fq + 4), g10 = *(const f32x4*)(gk + 32 + 8 * fq), g11 = *(const f32x4*)(gk + 32 + 8 * fq + 4);
                EPI_ROWS_BEGIN
                    const float ri = rinv1[row] * 0.03125f; const int b = row >> 12, s = row & 4095;
                    f32x4 a0 = acc[ai][0][m][0] * ri, a1 = acc[ai][0][m][1] * ri, c0 = acc[ai][1][m][0] * ri, c1 = acc[ai][1][m][1] * ri;
                    float ss = ((a0[0] * a0[0] + a0[1] * a0[1]) + (a0[2] * a0[2] + a0[3] * a0[3])) + ((a1[0] * a1[0] + a1[1] * a1[1]) + (a1[2] * a1[2] + a1[3] * a1[3]))
                             + ((c0[0] * c0[0] + c0[1] * c0[1]) + (c0[2] * c0[2] + c0[3] * c0[3])) + ((c1[0] * c1[0] + c1[1] * c1[1]) + (c1[2] * c1[2] + c1[3] * c1[3]));
                    ss += __shfl_xor(ss, 16); ss += __shfl_xor(ss, 32);
                    const float rn = 1.0f / sqrtf(ss * (1.0f / 64.f) + EPS);
                    a0 = a0 * rn * g00; a1 = a1 * rn * g01; c0 = c0 * rn * g10; c1 = c1 * rn * g11;
                    const float* tr = T16 + ((s >> 6) * 16 + 4 * fq) * 2; const float* tc = T16 + ((s & 63) * 16 + 4 * fq) * 2;
                    a0 = rope4t(a0, *(const f32x4*)tr); a1 = rope4t(a1, *(const f32x4*)(tr + 4)); c0 = rope4t(c0, *(const f32x4*)tc); c1 = rope4t(c1, *(const f32x4*)(tc + 4));
                    unsigned char* kp = (unsigned char*)Kb + ((size_t)(b * 2 + wc) * SEQ + s) * 64 + 8 * fq;
                    *(u32x2*)kp = pack8_fp8(a0, a1); *(u32x2*)(kp + 32) = pack8_fp8(c0, c1);
                    asm volatile("" ::: "memory");
                EPI_ROWS_END
            } else {
                EPI_ROWS_BEGIN
                    const float ri = rinv1[row] * 0.03125f; const int b = row >> 12, s = row & 4095;
                    store_vt(Vb + (size_t)(b * 2 + (wc - 2)) * 64 * SEQ, 8 * fq, s, acc[ai][0][m][0] * ri, acc[ai][0][m][1] * ri, acc[ai][1][m][0] * ri, acc[ai][1][m][1] * ri);
                EPI_ROWS_END
            }
        }
    }
};
struct EpiQup {
    static constexpr int MIDT = 0;
    const float* SSQ; bf16_t* Qa;
    __device__ __forceinline__ void operator()(const f32x4 (&acc)[2][2][4][2], const Unit& u, int wr, int wc, int fr, int fq) const {
        EPI_ROWS_BEGIN
            const f32x4* sp = (const f32x4*)(SSQ + (size_t)row * 16); const f32x4 s0 = sp[0], s1 = sp[1], s2 = sp[2];
            const float ss = ((s0[0] + s0[1]) + (s0[2] + s0[3])) + ((s1[0] + s1[1]) + (s1[2] + s1[3])) + ((s2[0] + s2[1]) + (s2[2] + s2[3]));
            const float ri = 1.0f / sqrtf(ss * (1.0f / QL) + EPS); const int b = row >> 12, s = row & 4095;
#pragma unroll
            for (int bj = 0; bj < 2; ++bj) { const int cg_ = u.pn * BM + EPI_COL(bj), h = cg_ / 96, d = cg_ - h * 96;
                *(u32x4*)(Qa + ((size_t)(b * 8 + h) * SEQ + s) * 96 + d) = pack8(acc[ai][bj][m][0] * ri, acc[ai][bj][m][1] * ri); }
        EPI_ROWS_END
    }
};
struct EpiKVup {
    static constexpr int MIDT = 0;
    const float* SSQ; const bf16_t* LAT; const float* gk; const float* T8; bf16_t* Ka; bf16_t* Va;
    __device__ __forceinline__ void operator()(const f32x4 (&acc)[2][2][4][2], const Unit& u, int wr, int wc, int fr, int fq) const {
        const int h = u.pn * 2 + (wc >> 1);
        if (wc & 1) {
            EPI_ROWS_BEGIN
                const f32x4 s3 = *(const f32x4*)(SSQ + (size_t)row * 16 + 12);
                const float ri = 1.0f / sqrtf(((s3[0] + s3[1]) + (s3[2] + s3[3])) * (1.0f / KVL) + EPS); const int b = row >> 12, s = row & 4095;
                store_vt(Va + (size_t)(b * 8 + h) * 64 * SEQ, 8 * fq, s, acc[ai][0][m][0] * ri, acc[ai][0][m][1] * ri, acc[ai][1][m][0] * ri, acc[ai][1][m][1] * ri);
            EPI_ROWS_END
        } else {
            const f32x4 g00 = *(const f32x4*)(gk + 8 * fq), g01 = *(const f32x4*)(gk + 8 * fq + 4), g10 = *(const f32x4*)(gk + 32 + 8 * fq), g11 = *(const f32x4*)(gk + 32 + 8 * fq + 4);
            const f32x4 gr0 = *(const f32x4*)(gk + 64 + 8 * fq), gr1 = *(const f32x4*)(gk + 64 + 8 * fq + 4);
            EPI_ROWS_BEGIN
                const f32x4 s3 = *(const f32x4*)(SSQ + (size_t)row * 16 + 12);
                const float ri = 1.0f / sqrtf(((s3[0] + s3[1]) + (s3[2] + s3[3])) * (1.0f / KVL) + EPS); const int b = row >> 12, s = row & 4095;
                f32x4 a0 = acc[ai][0][m][0] * ri, a1 = acc[ai][0][m][1] * ri, c0 = acc[ai][1][m][0] * ri, c1 = acc[ai][1][m][1] * ri, r0, r1;
                unpack8(*(const u32x4*)(LAT + (size_t)row * LATW + 1024 + 8 * fq), r0, r1);
                float ss = ((a0[0] * a0[0] + a0[1] * a0[1]) + (a0[2] * a0[2] + a0[3] * a0[3])) + ((a1[0] * a1[0] + a1[1] * a1[1]) + (a1[2] * a1[2] + a1[3] * a1[3]))
                         + ((c0[0] * c0[0] + c0[1] * c0[1]) + (c0[2] * c0[2] + c0[3] * c0[3])) + ((c1[0] * c1[0] + c1[1] * c1[1]) + (c1[2] * c1[2] + c1[3] * c1[3]))
                         + ((r0[0] * r0[0] + r0[1] * r0[1]) + (r0[2] * r0[2] + r0[3] * r0[3])) + ((r1[0] * r1[0] + r1[1] * r1[1]) + (r1[2] * r1[2] + r1[3] * r1[3]));
                ss += __shfl_xor(ss, 16); ss += __shfl_xor(ss, 32);
                const float rn = 1.0f / sqrtf(ss * (1.0f / 96.f) + EPS);
                r0 = r0 * rn * gr0; r1 = r1 * rn * gr1;
                const float* tp = T8 + (((fq < 2) ? (s >> 6) : (s & 63)) * 8 + ((4 * fq) & 7)) * 2;
                r0 = rope4t(r0, *(const f32x4*)tp); r1 = rope4t(r1, *(const f32x4*)(tp + 4));
                unsigned char* kp = (unsigned char*)Ka + ((size_t)(b * 8 + h) * SEQ + s) * 96 + 8 * fq;
                *(u32x2*)kp = pack8_fp8(a0 * rn * g00, a1 * rn * g01); *(u32x2*)(kp + 32) = pack8_fp8(c0 * rn * g10, c1 * rn * g11); *(u32x2*)(kp + 64) = pack8_fp8(r0, r1);
                asm volatile("" ::: "memory");
            EPI_ROWS_END
        }
    }
};
struct EpiMerge2 {
    static constexpr int MIDT = 4;
    const unsigned char* GATES; unsigned char* MG;
    __device__ __forceinline__ void mid(f32x4 (&acc)[2][2][4][2], const Unit& u, int wr, int wc, int fr, int fq) const {
        EPI_ROWS_BEGIN
#pragma unroll
            for (int bj = 0; bj < 2; ++bj) { const int c = u.pn * BM + EPI_COL(bj);
                f32x4 a0, a1, b0, b1; unpack8_fp8(*(const u32x2*)(GATES + (size_t)row * 2048 + c), a0, a1); unpack8_fp8(*(const u32x2*)(GATES + (size_t)row * 2048 + 1024 + c), b0, b1);
#pragma unroll
                for (int j = 0; j < 4; ++j) { acc[ai][bj][m][0][j] *= a0[j] * __builtin_amdgcn_rcpf(fmaxf(b0[j], 1e-30f)); acc[ai][bj][m][1][j] *= a1[j] * __builtin_amdgcn_rcpf(fmaxf(b1[j], 1e-30f)); } }
        EPI_ROWS_END4
    }
    __device__ __forceinline__ void operator()(const f32x4 (&acc)[2][2][4][2], const Unit& u, int wr, int wc, int fr, int fq) const {
        EPI_ROWS_BEGIN
#pragma unroll
            for (int bj = 0; bj < 2; ++bj) { const int c = u.pn * BM + EPI_COL(bj);
                f32x4 b0, b1; unpack8_fp8(*(const u32x2*)(GATES + (size_t)row * 2048 + 1024 + c), b0, b1);
                *(u32x2*)(MG + (size_t)row * DM + c) = pack8_fp8(acc[ai][bj][m][0] * b0 * 0.0001220703125f, acc[ai][bj][m][1] * b1 * 0.0001220703125f); }
        EPI_ROWS_END4
    }
};
struct EpiOut {
    static constexpr int MIDT = 0;
    const float* x; bf16_t* x1h; unsigned char* x1f8;
    __device__ __forceinline__ void operator()(const f32x4 (&acc)[2][2][4][2], const Unit& u, int wr, int wc, int fr, int fq) const {
        EPI_ROWS_BEGIN
#pragma unroll
            for (int bj = 0; bj < 2; ++bj) { const size_t o = (size_t)row * DM + u.pn * BM + EPI_COL(bj);
                const f32x4 v0 = acc[ai][bj][m][0] * 0.00048828125f + *(const f32x4*)(x + o), v1 = acc[ai][bj][m][1] * 0.00048828125f + *(const f32x4*)(x + o + 4);
                *(u32x4*)(x1h + o) = pack8_f16(v0, v1); *(u32x2*)(x1f8 + o) = pack8_fp8(v0, v1); }
        EPI_ROWS_END4
    }
};
struct EpiSwiGLU {
    static constexpr int MIDT = 0;
    const float* RG; unsigned char* ACT;
    __device__ __forceinline__ void operator()(const f32x4 (&acc)[2][2][4][2], const Unit& u, int wr, int wc, int fr, int fq) const {
        float rg_[2][4];
#pragma unroll
        for (int ai = 0; ai < 2; ++ai)
#pragma unroll
            for (int m = 0; m < 4; ++m) rg_[ai][m] = RG[u.pm * BM + ai * HALF + wr * 64 + m * 16 + fr];
        EPI_ROWS_BEGIN
            const float ri = rg_[ai][m] * 0.015625f;
            const float nl = ri * -1.4426950408889634f, r4 = 4.f * ri * ri;
            f32x4 a0, a1;
#pragma unroll
            for (int j = 0; j < 4; ++j) {
                a0[j] = (acc[ai][0][m][0][j] * acc[ai][1][m][0][j]) * r4 * __builtin_amdgcn_rcpf(1.f + __builtin_amdgcn_exp2f(acc[ai][0][m][0][j] * nl));
                a1[j] = (acc[ai][0][m][1][j] * acc[ai][1][m][1][j]) * r4 * __builtin_amdgcn_rcpf(1.f + __builtin_amdgcn_exp2f(acc[ai][0][m][1][j] * nl)); }
            *(u32x2*)(ACT + (size_t)row * FF + u.pn * HALF + wc * 32 + fq * 8) = pack8_fp8(a0, a1);
        EPI_ROWS_END
    }
};
struct EpiDown {
    static constexpr int MIDT = 0;
    const float* GATEV; unsigned char* YE;
    __device__ __forceinline__ void operator()(const f32x4 (&acc)[2][2][4][2], const Unit& u, int wr, int wc, int fr, int fq) const {
        float gv_[2][4];
#pragma unroll
        for (int ai = 0; ai < 2; ++ai)
#pragma unroll
            for (int m = 0; m < 4; ++m) gv_[ai][m] = GATEV[u.pm * BM + ai * HALF + wr * 64 + m * 16 + fr];
        EPI_ROWS_BEGIN
            const float gv = gv_[ai][m] * 0.25f;
#pragma unroll
            for (int bj = 0; bj < 2; ++bj) *(u32x2*)(YE + (size_t)row * DM + u.pn * BM + EPI_COL(bj)) = pack8_fp8(acc[ai][bj][m][0] * gv, acc[ai][bj][m][1] * gv);
        EPI_ROWS_END
    }
};
}

namespace att {
using bf16 = __hip_bfloat16;
constexpr int NW = 8, QBLK = 32, KVBLK = 64, DV = 64;
constexpr float THR = 8.f;
#define SBAR() __builtin_amdgcn_sched_barrier(0)
__device__ __forceinline__ int crow(int r, int hi) { return (r & 3) + 8 * (r >> 2) + 4 * hi; }
__device__ __forceinline__ unsigned cvtpk(float lo, float hi) { unsigned r; asm volatile("v_cvt_pk_bf16_f32 %0, %1, %2" : "=v"(r) : "v"(lo), "v"(hi)); return r; }

template <int DQK> struct Cfg4 {
    static constexpr int NK = (DQK + 63) / 64;
    static constexpr int KSTR = (DQK == 64) ? 80 : 144;
    static constexpr int VSTR = 144;
    static constexpr int KT = KVBLK * KSTR, VT = DV * VSTR;
    static constexpr int OFF_K = 0, OFF_V = 2 * KT, OFF_WS = OFF_V + 3 * VT, OFF_OST = OFF_WS + NW * 64 * 4, BYTES = OFF_OST + NW * 4096;
    static constexpr int NPK = KVBLK * DQK / 16;
};
typedef int v8i_t __attribute__((ext_vector_type(8)));
typedef int v4i_t __attribute__((ext_vector_type(4)));

template <int DQK>
__device__ __forceinline__ void load_q8(v8i_t (&qf)[Cfg4<DQK>::NK], const bf16_t* Qrow, const float* __restrict__ g, const float* __restrict__ TB, int spos, int hi) {
    constexpr int NK = Cfg4<DQK>::NK; constexpr float CS8 = ((DQK == 96) ? 0.14724444f : 0.18033688f) * 8.f;
    f32x4 v[NK][8]; float ss = 0.f;
#pragma unroll
    for (int j = 0; j < NK; ++j) { const bool valid = (DQK == 64) || (j == 0) || (hi == 0);
#pragma unroll
        for (int q = 0; q < 4; ++q) { u32x4 w = {0u, 0u, 0u, 0u}; if (valid) w = *reinterpret_cast<const u32x4*>(Qrow + 64 * j + 32 * hi + 8 * q); unpack8(w, v[j][2 * q], v[j][2 * q + 1]); }
#pragma unroll
        for (int q = 0; q < 8; ++q) ss += (v[j][q][0] * v[j][q][0] + v[j][q][1] * v[j][q][1]) + (v[j][q][2] * v[j][q][2] + v[j][q][3] * v[j][q][3]); }
    ss += __shfl_xor(ss, 32);
    const float rn = CS8 / sqrtf(ss * (1.0f / DQK) + EPS);
    const int prow = spos >> 6, pcol = spos & 63;
#pragma unroll
    for (int j = 0; j < NK; ++j) { const bool valid = (DQK == 64) || (j == 0) || (hi == 0); const int d0 = valid ? 64 * j + 32 * hi : 0;
#pragma unroll
        for (int q = 0; q < 8; ++q) { v[j][q] = v[j][q] * rn * *(const f32x4*)(g + d0 + 4 * q);
            if (DQK == 64) v[j][q] = rope4t(v[j][q], *(const f32x4*)(TB + ((hi ? pcol : prow) * 16 + 2 * q) * 2));
            else if (j == 1) v[j][q] = rope4t(v[j][q], *(const f32x4*)(TB + (((q < 4) ? prow : pcol) * 8 + 2 * (q & 3)) * 2)); }
        u32x2 w0 = pack8_fp8(v[j][0], v[j][1]), w1 = pack8_fp8(v[j][2], v[j][3]), w2 = pack8_fp8(v[j][4], v[j][5]), w3 = pack8_fp8(v[j][6], v[j][7]);
        if (!valid) { w0 = (u32x2){0u, 0u}; w1 = w0; w2 = w0; w3 = w0; }
        qf[j] = (v8i_t){(int)w0.x, (int)w0.y, (int)w1.x, (int)w1.y, (int)w2.x, (int)w2.y, (int)w3.x, (int)w3.y}; }
}

template <int DQK, bool SHIFT>
__device__ __forceinline__ void attn_step4(f32x16& C0, f32x16& C1, f32x16& N0, f32x16& N1, bf16x8& W0, bf16x8& W1, bf16x8& W2, bf16x8& W3,
                                           const bf16x8& R0, const bf16x8& R1, const bf16x8& R2, const bf16x8& R3, f32x16 (&o)[2], float& l0, float& l1, float& l2, float& l3,
                                           const v8i_t (&qf)[Cfg4<DQK>::NK], const LAS char* kp, const LAS char* vp, int sc_k, int sc_q, float nsh) {
    constexpr int KSTR = Cfg4<DQK>::KSTR, NK = Cfg4<DQK>::NK, NQ = 2 * NK, NS = NQ + 8;
    v8i_t kq[NQ]; bf16x8 vfr_[8];
#define SLOT_ISQ(s) ((DQK == 64) ? ((s) == 0 || (s) == 5) : (((s) % 3) == 0))
#define SLOT_IDX(s) ((DQK == 64) ? (SLOT_ISQ(s) ? ((s) == 5) : ((s) < 5 ? (s) - 1 : (s) - 2)) : (SLOT_ISQ(s) ? (s) / 3 : (s) - (s) / 3 - 1))
#define FRAG_RD(s) do { if ((s) < NS) { if (SLOT_ISQ(s)) { const int i_ = SLOT_IDX(s); const LAS char* p_ = kp + (i_ & 1) * 32 * KSTR + (i_ >> 1) * 64; \
            kq[i_] = __builtin_shufflevector(*(const LAS v4i_t*)p_, *(const LAS v4i_t*)(p_ + 16), 0, 1, 2, 3, 4, 5, 6, 7); } \
        else { const int j_ = SLOT_IDX(s); vfr_[j_] = *(const LAS bf16x8*)(vp + (j_ & 1) * 32 * Cfg4<DQK>::VSTR + (j_ >> 1) * 32); } } } while (0)
#define EXPQ(P, B) do { if (SHIFT) { P[B] += nsh; P[B + 1] += nsh; P[B + 2] += nsh; P[B + 3] += nsh; } \
        P[B] = __builtin_amdgcn_exp2f(P[B]); P[B + 1] = __builtin_amdgcn_exp2f(P[B + 1]); P[B + 2] = __builtin_amdgcn_exp2f(P[B + 2]); P[B + 3] = __builtin_amdgcn_exp2f(P[B + 3]); } while (0)
#define ADDQ(P, B) do { l0 += P[B]; l1 += P[B + 1]; l2 += P[B + 2]; l3 += P[B + 3]; } while (0)
#define PKN(P, BASE, OUT) do { u32x4 w_ = {cvtpk(P[BASE + 0], P[BASE + 1]), cvtpk(P[BASE + 2], P[BASE + 3]), cvtpk(P[BASE + 4], P[BASE + 5]), cvtpk(P[BASE + 6], P[BASE + 7])}; OUT = __builtin_bit_cast(bf16x8, w_); } while (0)
#define CHUNK(g) do { \
        if ((g) == 0) { EXPQ(C0, 4); ADDQ(C0, 0); } else if ((g) == 1) { EXPQ(C0, 8); ADDQ(C0, 4); } else if ((g) == 2) { PKN(C0, 0, W0); EXPQ(C0, 12); } \
        else if ((g) == 3) { ADDQ(C0, 8); EXPQ(C1, 0); } else if ((g) == 4) { ADDQ(C0, 12); PKN(C0, 8, W1); } else if ((g) == 5) { EXPQ(C1, 4); ADDQ(C1, 0); } \
        else if ((g) == 6) { EXPQ(C1, 8); ADDQ(C1, 4); } else if ((g) == 7) { PKN(C1, 0, W2); EXPQ(C1, 12); } else if ((g) == 8) { ADDQ(C1, 8); ADDQ(C1, 12); } \
        else if ((g) == 9) { PKN(C1, 8, W3); } } while (0)
    FRAG_RD(0); FRAG_RD(1);
    EXPQ(C0, 0);
    __builtin_amdgcn_sched_barrier(0);
#pragma unroll
    for (int s = 0; s < NS; ++s) {
        if (SLOT_ISQ(s)) { const int i = SLOT_IDX(s);
            if ((i >> 1) == 0) { if (i & 1) asm volatile("v_mfma_scale_f32_32x32x64_f8f6f4 %0, %1, %2, 0, %3, %4 op_sel_hi:[0,0,0]" : "=&v"(N1) : "v"(kq[i]), "v"(qf[0]), "v"(sc_k), "v"(sc_q));
                                 else       asm volatile("v_mfma_scale_f32_32x32x64_f8f6f4 %0, %1, %2, 0, %3, %4 op_sel_hi:[0,0,0]" : "=&v"(N0) : "v"(kq[i]), "v"(qf[0]), "v"(sc_k), "v"(sc_q)); }
            else               { if (i & 1) asm volatile("v_mfma_scale_f32_32x32x64_f8f6f4 %0, %1, %2, %0, %3, %4 op_sel_hi:[0,0,0]" : "+v"(N1) : "v"(kq[i]), "v"(qf[NK - 1]), "v"(sc_k), "v"(sc_q));
                                 else       asm volatile("v_mfma_scale_f32_32x32x64_f8f6f4 %0, %1, %2, %0, %3, %4 op_sel_hi:[0,0,0]" : "+v"(N0) : "v"(kq[i]), "v"(qf[NK - 1]), "v"(sc_k), "v"(sc_q)); }
        } else { const int j = SLOT_IDX(s);
            const bf16x8 pa = ((j >> 1) == 0) ? R0 : ((j >> 1) == 1) ? R1 : ((j >> 1) == 2) ? R2 : R3;
            o[j & 1] = __builtin_amdgcn_mfma_f32_32x32x16_bf16(pa, vfr_[j], o[j & 1], 0, 0, 0); }
        FRAG_RD(s + 2);
        CHUNK(s);
        __builtin_amdgcn_sched_barrier(0);
    }
#undef SLOT_ISQ
#undef SLOT_IDX
#undef FRAG_RD
#undef EXPQ
#undef ADDQ
#undef PKN
#undef CHUNK
}

template <int DQK, int LDO, bool SHIFT>
__device__ __forceinline__ void attn_unit4(const bf16_t* __restrict__ Qb, const unsigned char* __restrict__ Kh, const bf16_t* __restrict__ Vh, unsigned char* __restrict__ Ob, int seq, LAS char* lds, float negMref, const float* gq, const float* TB, int q0) {
    using C = Cfg4<DQK>; constexpr int NK = C::NK;
    int tid = threadIdx.x; asm volatile("" : "+v"(tid));
    const int wid = tid >> 6, lane = tid & 63, r32 = lane & 31, hi = lane >> 5;
    LAS char* K_lds = lds + C::OFF_K; LAS char* V_lds = lds + C::OFF_V;
    f32x16 o[2] = {}; v8i_t qf[NK]; float l0 = 0.f, l1 = 0.f, l2 = 0.f, l3 = 0.f;
    const int sc_k = 0x7f7f7f7f, sc_q = 0x7c7c7c7c;
    constexpr int CPR = DQK / 16;
    const bool kact = tid < C::NPK; const int kr = tid / CPR, kc = tid - kr * CPR, kst0 = kr * C::KSTR + kc * 16;
    const int sr = tid >> 3, sc = (tid & 7) * 8, vst0 = sr * C::VSTR + sc * 2;
    if (DQK == 96) {
        if (tid < 256) { const int slot = tid >> 7, r_ = (tid >> 1) & 63, c_ = tid & 1; *(LAS u32x4*)(K_lds + slot * C::KT + r_ * C::KSTR + 96 + 16 * c_) = (u32x4){0u, 0u, 0u, 0u}; } }
    const LAS char* kfr = K_lds + r32 * C::KSTR + hi * 32;
    const LAS char* vfr = V_lds + r32 * C::VSTR + hi * 16;
    u32x4 ks0 = {0u, 0u, 0u, 0u}; bf16x8 vs;
#define LOADK(t) do { if (kact) ks0 = *reinterpret_cast<const u32x4*>(Kh + (long)(t) * KVBLK * DQK + tid * 16); } while (0)
#define LOADV(t) do { vs = *reinterpret_cast<const bf16x8*>(&Vh[(long)sr * seq + (t) * KVBLK + sc]); } while (0)
#define WRITEK(slotoff) do { if (kact) *(LAS u32x4*)(K_lds + (slotoff) + kst0) = ks0; } while (0)
#define WRITEV(slotoff) do { *(LAS bf16x8*)(V_lds + (slotoff) + vst0) = vs; } while (0)
    const int NT = seq / KVBLK;
    {
        u32x4 kp1 = {0u, 0u, 0u, 0u};
        LOADK(0); if (kact) kp1 = *reinterpret_cast<const u32x4*>(Kh + (long)KVBLK * DQK + tid * 16); LOADV(0);
        load_q8<DQK>(qf, Qb + (long)(wid * QBLK + r32) * DQK, gq, TB, q0 + wid * QBLK + r32, hi);
        WRITEK(0); WRITEV(0); if (kact) *(LAS u32x4*)(K_lds + C::KT + kst0) = kp1;
        LOADK(2); LOADV(1);
    }
    __syncthreads();
    f32x16 pA0, pA1, pB0, pB1; bf16x8 xa0 = {}, xa1 = {}, xa2 = {}, xa3 = {}, ya0 = {}, ya1 = {}, ya2 = {}, ya3 = {};
    {
#pragma unroll
        for (int j = 0; j < NK; ++j) {
            const LAS char* p0_ = kfr + j * 64; const LAS char* p1_ = p0_ + 32 * C::KSTR;
            const v8i_t k0_ = __builtin_shufflevector(*(const LAS v4i_t*)p0_, *(const LAS v4i_t*)(p0_ + 16), 0, 1, 2, 3, 4, 5, 6, 7);
            const v8i_t k1_ = __builtin_shufflevector(*(const LAS v4i_t*)p1_, *(const LAS v4i_t*)(p1_ + 16), 0, 1, 2, 3, 4, 5, 6, 7);
            if (j == 0) { asm volatile("v_mfma_scale_f32_32x32x64_f8f6f4 %0, %1, %2, 0, %3, %4 op_sel_hi:[0,0,0]" : "=&v"(pA0) : "v"(k0_), "v"(qf[0]), "v"(sc_k), "v"(sc_q));
                          asm volatile("v_mfma_scale_f32_32x32x64_f8f6f4 %0, %1, %2, 0, %3, %4 op_sel_hi:[0,0,0]" : "=&v"(pA1) : "v"(k1_), "v"(qf[0]), "v"(sc_k), "v"(sc_q)); }
            else        { asm volatile("v_mfma_scale_f32_32x32x64_f8f6f4 %0, %1, %2, %0, %3, %4 op_sel_hi:[0,0,0]" : "+v"(pA0) : "v"(k0_), "v"(qf[NK - 1]), "v"(sc_k), "v"(sc_q));
                          asm volatile("v_mfma_scale_f32_32x32x64_f8f6f4 %0, %1, %2, %0, %3, %4 op_sel_hi:[0,0,0]" : "+v"(pA1) : "v"(k1_), "v"(qf[NK - 1]), "v"(sc_k), "v"(sc_q)); } }
        asm volatile("s_nop 15\n\ts_nop 15" ::: "memory");
    }
#define VFRAG(L, H) (bf16x8){L[0], L[1], L[2], L[3], H[0], H[1], H[2], H[3]}
#define STEP(C0, C1, N0, N1, W0, W1, W2, W3, R0, R1, R2, R3, koff, voff) attn_step4<DQK, SHIFT>(C0, C1, N0, N1, W0, W1, W2, W3, R0, R1, R2, R3, o, l0, l1, l2, l3, qf, kfr + (koff), vfr + (voff), sc_k, sc_q, negMref)
    int kcur = C::KT, vprev = 0, vnext = C::VT;
    for (int t = 0; t < NT; t += 2) {
        __syncthreads();
        WRITEK(C::KT - kcur); WRITEV(vnext);
        { const int tk = (t + 3 < NT) ? t + 3 : NT - 1, tv = (t + 2 < NT) ? t + 2 : NT - 1; LOADK(tk); LOADV(tv); }
        STEP(pA0, pA1, pB0, pB1, xa0, xa1, xa2, xa3, ya0, ya1, ya2, ya3, kcur, vprev);
        vprev = (t == 0) ? 0 : (vprev == 2 * C::VT ? 0 : vprev + C::VT); vnext = (vnext == 2 * C::VT) ? 0 : vnext + C::VT; kcur = C::KT - kcur;
        __syncthreads();
        WRITEK(C::KT - kcur); WRITEV(vnext);
        { const int tk = (t + 4 < NT) ? t + 4 : NT - 1, tv = (t + 3 < NT) ? t + 3 : NT - 1; LOADK(tk); LOADV(tv); }
        STEP(pB0, pB1, pA0, pA1, ya0, ya1, ya2, ya3, xa0, xa1, xa2, xa3, kcur, vprev);
        vprev = (vprev == 2 * C::VT) ? 0 : vprev + C::VT; vnext = (vnext == 2 * C::VT) ? 0 : vnext + C::VT; kcur = C::KT - kcur;
    }
    {   const LAS char* vp_ = vfr + vprev;
#pragma unroll
        for (int d0 = 0; d0 < 2; ++d0) {
            const bf16x8 f0 = *(const LAS bf16x8*)(vp_ + d0 * 32 * C::VSTR), f1 = *(const LAS bf16x8*)(vp_ + d0 * 32 * C::VSTR + 32), f2 = *(const LAS bf16x8*)(vp_ + d0 * 32 * C::VSTR + 64), f3 = *(const LAS bf16x8*)(vp_ + d0 * 32 * C::VSTR + 96);
            o[d0] = __builtin_amdgcn_mfma_f32_32x32x16_bf16(ya0, f0, o[d0], 0, 0, 0); o[d0] = __builtin_amdgcn_mfma_f32_32x32x16_bf16(ya1, f1, o[d0], 0, 0, 0);
            o[d0] = __builtin_amdgcn_mfma_f32_32x32x16_bf16(ya2, f2, o[d0], 0, 0, 0); o[d0] = __builtin_amdgcn_mfma_f32_32x32x16_bf16(ya3, f3, o[d0], 0, 0, 0); }
    }
    float l_reg = (l0 + l1) + (l2 + l3);
    { auto rr = __builtin_amdgcn_permlane32_swap(__float_as_uint(l_reg), __float_as_uint(l_reg), false, false); l_reg = __uint_as_float(rr[0]) + __uint_as_float(rr[1]); }
    LAS float* ws = (LAS float*)(lds + C::OFF_WS) + wid * 64;
    if (hi == 0) ws[r32] = l_reg;
    asm volatile("s_waitcnt lgkmcnt(0)" ::: "memory");
    float rli[16];
#pragma unroll
    for (int r = 0; r < 16; ++r) rli[r] = __builtin_amdgcn_rcpf(ws[crow(r, hi)]);
    unsigned char* Ow = Ob + (long)(wid * QBLK) * LDO;
    { LAS unsigned char* stg = (LAS unsigned char*)(lds + C::OFF_OST) + wid * 2048;
#pragma unroll
      for (int r = 0; r < 16; ++r) { const int orow = crow(r, hi); const float sc_ = rli[r] * 64.f;
          const int w_ = __builtin_amdgcn_cvt_pk_fp8_f32(o[0][r] * sc_, o[1][r] * sc_, 0, false);
          stg[orow * 64 + r32] = (unsigned char)(w_ & 0xff); stg[orow * 64 + 32 + r32] = (unsigned char)((w_ >> 8) & 0xff); }
      asm volatile("s_waitcnt lgkmcnt(0)" ::: "memory");
#pragma unroll
      for (int i = 0; i < 2; ++i) { const int row = i * 16 + (lane >> 2), ch = lane & 3; const u32x4 v = *(const LAS u32x4*)(stg + row * 64 + ch * 16); *(u32x4*)(Ow + (long)row * LDO + ch * 16) = v; } }
    asm volatile("s_waitcnt lgkmcnt(0)" ::: "memory"); __syncthreads();
#undef LOADK
#undef LOADV
#undef WRITEK
#undef WRITEV
#undef VFRAG
#undef STEP
}
#undef SBAR
}

constexpr size_t MiB = 1u << 20;
constexpr size_t WS_CTL = 0, CTL_ZERO_BYTES = 64 * 1024;
constexpr size_t WS_RINV1 = 1 * MiB, WS_RINV2 = 1 * MiB + 512 * 1024, WS_SSQ = 2 * MiB, WS_AFF = 4 * MiB, WS_IDX = 6 * MiB, WS_GATEV = 6 * MiB + 256 * 1024, WS_RG = 6 * MiB + 512 * 1024, WS_INV = 7 * MiB;
constexpr size_t WS_ROPE16 = 6 * MiB + 768 * 1024, WS_ROPE8 = WS_ROPE16 + 8192;
constexpr size_t WS_WIN = 9 * MiB, WS_WQUP = 17 * MiB, WS_WKVUP = 18 * MiB + 256 * 1024, WS_WA = 19 * MiB, WS_WB = 20 * MiB, WS_WO = 21 * MiB;
constexpr size_t WS_XB = 24 * MiB;
constexpr size_t WS_MG = 56 * MiB;
constexpr size_t WS_LAT = 88 * MiB;
constexpr size_t WS_GATES = 154 * MiB;
constexpr size_t WS_X1H = WS_GATES;
constexpr size_t WS_QB = 218 * MiB, WS_KB = 250 * MiB, WS_VB = 254 * MiB, WS_QA = 262 * MiB, WS_KA = 310 * MiB, WS_VA = 334 * MiB;
constexpr size_t WS_WGU = 366 * MiB, WS_WD = 398 * MiB;
constexpr size_t WS_ACT = 88 * MiB, WS_XE = 218 * MiB;
constexpr size_t WS_END = 414 * MiB;


#define XB_TMO      128
#define XB_XCNT(j)  (256  + 64 * (j))
#define XB_XSUB(j)  (1280 + 64 * (j))
#define XB_XGEN(j)  (2304 + 64 * (j))
#define XB_TOP      3328
#define XB_TOPGEN   3392
#define XCD_BAR_WORDS 3456
#define XB_SPIN_CAP (1u << 22)
__device__ __forceinline__ unsigned xb_ld(unsigned* p)              { return __hip_atomic_load(p, __ATOMIC_RELAXED, __HIP_MEMORY_SCOPE_AGENT); }
__device__ __forceinline__ unsigned xb_add(unsigned* p, unsigned v) { return __hip_atomic_fetch_add(p, v, __ATOMIC_RELAXED, __HIP_MEMORY_SCOPE_AGENT); }
__device__ __forceinline__ unsigned xb_xcc_id() { return (unsigned)__builtin_amdgcn_s_getreg((3 << 11) | 20) & 0xFu; }
#define XB_SPIN(cond, bar) do { unsigned _sp = 0; while (cond) { __builtin_amdgcn_s_sleep(1); \
    if ((++_sp & 255u) == 0u) { if (xb_ld(&(bar)[XB_TMO])) break; if (_sp > XB_SPIN_CAP) { atomicAdd(&(bar)[XB_TMO], 1u); break; } } } } while (0)
struct XcdBarrier { unsigned* bar; unsigned x; volatile LAS unsigned* st; };
__device__ __forceinline__ XcdBarrier xcd_barrier_post(unsigned* bar, volatile LAS unsigned* st) {
    XcdBarrier b; b.bar = bar; b.x = xb_xcc_id(); b.st = st;
    if (threadIdx.x == 0) st[2] = xb_add(&bar[XB_XCNT(b.x)], 1u);
    return b;
}
__device__ __forceinline__ void xcd_barrier_complete(unsigned* bar, unsigned x, unsigned& nloc, unsigned& nx, unsigned& uni) {
    const unsigned G = gridDim.x * gridDim.y * gridDim.z;
    unsigned sum, cnt, mine, sp = 0u, u32c;
    for (;;) {
        sum = 0u; cnt = 0u; mine = 0u; u32c = 0u;
#pragma unroll
        for (unsigned j = 0; j < 16; ++j) { const unsigned c = xb_ld(&bar[XB_XCNT(j)]); sum += c; cnt += (c > 0u) ? 1u : 0u; mine = (j == x) ? c : mine; u32c += (j < 8u && c == 32u) ? 1u : 0u; }
        if (sum == G) break;
        __builtin_amdgcn_s_sleep(1);
        if ((++sp & 255u) == 0u) { if (xb_ld(&bar[XB_TMO])) break; if (sp > XB_SPIN_CAP) { atomicAdd(&bar[XB_TMO], 1u); break; } }
    }
    nloc = mine > 0u ? mine : 1u; nx = cnt > 0u ? cnt : 1u;
    uni = (sum == G && G == 256u && cnt == 8u && u32c == 8u) ? 1u : 0u;
}
__device__ __forceinline__ void xcd_barrier(const XcdBarrier& b) {
    asm volatile("s_waitcnt vmcnt(0)" ::: "memory");
    __syncthreads();
    if (threadIdx.x == 0) {
        unsigned* bar = b.bar;
        __builtin_amdgcn_s_waitcnt(0);
        unsigned nloc = b.st[0], nx = b.st[1];
        if (nloc == 0u) { unsigned uni; xcd_barrier_complete(bar, b.x, nloc, nx, uni); b.st[0] = nloc; b.st[1] = nx; b.st[3] = uni; }
        const unsigned old = xb_add(&bar[XB_XSUB(b.x)], 1u);
        const unsigned gen = old / nloc;
        if (old + 1u == (gen + 1u) * nloc) {
            __builtin_amdgcn_fence(__ATOMIC_RELEASE, "agent");
            asm volatile("s_waitcnt vmcnt(0)" ::: "memory");
            const unsigned og = xb_add(&bar[XB_TOP], 1u);
            const unsigned tg = og / nx;
            if (og + 1u == (tg + 1u) * nx) xb_add(&bar[XB_TOPGEN], 1u);
            else XB_SPIN(xb_ld(&bar[XB_TOPGEN]) == tg, bar);
            __builtin_amdgcn_fence(__ATOMIC_ACQUIRE, "agent");
            xb_add(&bar[XB_XGEN(b.x)], 1u);
            asm volatile("s_waitcnt vmcnt(0)" ::: "memory");
        } else {
            XB_SPIN(xb_ld(&bar[XB_XGEN(b.x)]) == gen, bar);
            __builtin_amdgcn_fence(__ATOMIC_ACQUIRE, "agent");
            asm volatile("s_waitcnt vmcnt(0)" ::: "memory");
        }
    }
    __syncthreads();
}

__device__ __forceinline__ void xcd_barrier_local(const XcdBarrier& b) {
    asm volatile("s_waitcnt vmcnt(0)" ::: "memory");
    __syncthreads();
    if (threadIdx.x == 0) {
        unsigned* bar = b.bar;
        __builtin_amdgcn_s_waitcnt(0);
        const unsigned nloc = b.st[0];
        const unsigned old = xb_add(&bar[XB_XSUB(b.x)], 1u);
        const unsigned gen = old / nloc;
        if (old + 1u == (gen + 1u) * nloc) xb_add(&bar[XB_XGEN(b.x)], 1u);
        else XB_SPIN(xb_ld(&bar[XB_XGEN(b.x)]) == gen, bar);
        __builtin_amdgcn_fence(__ATOMIC_ACQUIRE, "agent");
        asm volatile("s_waitcnt vmcnt(0)" ::: "memory");
    }
    __syncthreads();
}

constexpr int LDS_BYTES = 147456;
struct Args {
    const float* in[21]; float* out; unsigned char* ws; int ph_lo, ph_hi;
};
__device__ __forceinline__ float wave_sum(float v) {
#pragma unroll
    for (int o = 1; o < 64; o <<= 1) v += __shfl_xor(v, o);
    return v;
}
__device__ __forceinline__ void tr_item(const float* W, int K, int N, int k0, int n0, bf16_t* WT, int prow0, const float* g, LAS float* scr, int lane) {
#pragma unroll 8
    for (int i = 0; i < 32; ++i) { const int kk = 2 * i + (lane >> 5); float w = W[(size_t)(k0 + kk) * N + n0 + (lane & 31)]; if (g) w *= g[k0 + kk]; scr[kk * 33 + (lane & 31)] = w; }
    asm volatile("s_waitcnt lgkmcnt(0)" ::: "memory");
    const int c = lane & 7;
#pragma unroll
    for (int j = 0; j < 4; ++j) { const int n = (lane >> 3) + 8 * j; const LAS float* s = scr + (8 * c) * 33 + n;
        u32x4 o; o.x = cvt_pk_bf16(s[0 * 33], s[1 * 33]); o.y = cvt_pk_bf16(s[2 * 33], s[3 * 33]); o.z = cvt_pk_bf16(s[4 * 33], s[5 * 33]); o.w = cvt_pk_bf16(s[6 * 33], s[7 * 33]);
        *(u32x4*)(WT + (size_t)(prow0 + n) * K + k0 + 8 * c) = o; }
    asm volatile("s_waitcnt lgkmcnt(0)" ::: "memory");
}
__device__ __forceinline__ void tr_item64(const float* W, int K, int N, int k0, int n0, bf16_t* WT, int prow0, const float* g, LAS float* scr, int lane) {
    f32x4 v[16]; const int kr = lane >> 4, n4 = (lane & 15) * 4;
#pragma unroll
    for (int i = 0; i < 16; ++i) v[i] = *(const f32x4*)(W + (size_t)(k0 + 4 * i + kr) * N + n0 + n4);
#pragma unroll
    for (int i = 0; i < 16; ++i) { const int k = 4 * i + kr; const float gs = g ? g[k0 + k] : 1.f; LAS float* d = scr + k * 65 + n4;
        d[0] = v[i][0] * gs; d[1] = v[i][1] * gs; d[2] = v[i][2] * gs; d[3] = v[i][3] * gs; }
    asm volatile("s_waitcnt lgkmcnt(0)" ::: "memory");
    const int c = lane >> 3;
#pragma unroll
    for (int j = 0; j < 8; ++j) { const int n = (lane & 7) + 8 * j; const LAS float* s = scr + (8 * c) * 65 + n;
        u32x4 o; o.x = cvt_pk_bf16(s[0 * 65], s[1 * 65]); o.y = cvt_pk_bf16(s[2 * 65], s[3 * 65]); o.z = cvt_pk_bf16(s[4 * 65], s[5 * 65]); o.w = cvt_pk_bf16(s[6 * 65], s[7 * 65]);
        *(u32x4*)(WT + (size_t)(prow0 + n) * K + k0 + 8 * c) = o; }
    asm volatile("s_waitcnt lgkmcnt(0)" ::: "memory");
}
__device__ __forceinline__ void tr_item64_f8(const float* W, int K, int N, int k0, int n0, unsigned char* WT, int prow0, const float* g, float sc, LAS float* scr, int lane) {
    f32x4 v[16]; const int kr = lane >> 4, n4 = (lane & 15) * 4;
#pragma unroll
    for (int i = 0; i < 16; ++i) v[i] = *(const f32x4*)(W + (size_t)(k0 + 4 * i + kr) * N + n0 + n4);
#pragma unroll
    for (int i = 0; i < 16; ++i) { const int k = 4 * i + kr; const float gs = (g ? g[k0 + k] : 1.f) * sc; LAS float* d = scr + k * 65 + n4;
        d[0] = v[i][0] * gs; d[1] = v[i][1] * gs; d[2] = v[i][2] * gs; d[3] = v[i][3] * gs; }
    asm volatile("s_waitcnt lgkmcnt(0)" ::: "memory");
    const int kc = lane >> 4;
#pragma unroll
    for (int j = 0; j < 4; ++j) { const int n = (lane & 15) + 16 * j; const LAS float* sp = scr + (16 * kc) * 65 + n;
        u32x4 o; unsigned w_[4];
#pragma unroll
        for (int q = 0; q < 4; ++q) { int t = __builtin_amdgcn_cvt_pk_fp8_f32(sp[(4 * q) * 65], sp[(4 * q + 1) * 65], 0, false); t = __builtin_amdgcn_cvt_pk_fp8_f32(sp[(4 * q + 2) * 65], sp[(4 * q + 3) * 65], t, true); w_[q] = (unsigned)t; }
        o.x = w_[0]; o.y = w_[1]; o.z = w_[2]; o.w = w_[3];
        *(u32x4*)(WT + (size_t)(prow0 + n) * K + k0 + 16 * kc) = o; }
    asm volatile("s_waitcnt lgkmcnt(0)" ::: "memory");
}
__device__ __forceinline__ void tr_item_f8(const float* W, int K, int N, int k0, int n0, unsigned char* WT, int prow0, const float* g, float sc, LAS float* scr, int lane) {
#pragma unroll 8
    for (int i = 0; i < 32; ++i) { const int kk = 2 * i + (lane >> 5); float w = W[(size_t)(k0 + kk) * N + n0 + (lane & 31)] * sc; if (g) w *= g[k0 + kk]; scr[kk * 33 + (lane & 31)] = w; }
    asm volatile("s_waitcnt lgkmcnt(0)" ::: "memory");
    const int n = lane & 31;
#pragma unroll
    for (int j = 0; j < 2; ++j) { const int kc = (lane >> 5) + 2 * j; const LAS float* sp = scr + (16 * kc) * 33 + n; unsigned w_[4];
#pragma unroll
        for (int q = 0; q < 4; ++q) { int t = __builtin_amdgcn_cvt_pk_fp8_f32(sp[(4 * q) * 33], sp[(4 * q + 1) * 33], 0, false); t = __builtin_amdgcn_cvt_pk_fp8_f32(sp[(4 * q + 2) * 33], sp[(4 * q + 3) * 33], t, true); w_[q] = (unsigned)t; }
        u32x4 o; o.x = w_[0]; o.y = w_[1]; o.z = w_[2]; o.w = w_[3];
        *(u32x4*)(WT + (size_t)(prow0 + n) * K + k0 + 16 * kc) = o; }
    asm volatile("s_waitcnt lgkmcnt(0)" ::: "memory");
}
__device__ __forceinline__ int win_prow(int n) {
    if (n < 1056) return n;
    if (n < 1568) return 1280 + (n - 1056);
    if (n < 1696) { const int j = n - 1568; return 1792 + ((j >> 5) & 1) * 128 + 32 * (j >> 6); }
    if (n < 1824) { const int j = n - 1696; return 1792 + ((j >> 5) & 1) * 128 + 32 * (2 + (j >> 6)); }
    return 2048 + (n - 1824);
}
__device__ __forceinline__ int block_scan(int v, int& tot, LAS int* scr, int tid) {
    const int lane = tid & 63, w = tid >> 6; int x = v;
#pragma unroll
    for (int o = 1; o < 64; o <<= 1) { const int y = __shfl_up(x, o); if (lane >= o) x += y; }
    __syncthreads();
    if (lane == 63) scr[w] = x;
    __syncthreads();
    int base = 0, t = 0;
#pragma unroll
    for (int i = 0; i < 8; ++i) { const int s = scr[i]; if (i < w) base += s; t += s; }
    tot = t; return base + x - v;
}

__global__ void __launch_bounds__(512, 2) fwd_kernel(const Args args) {
    extern __shared__ __attribute__((aligned(16))) unsigned char lds[];
    LAS unsigned char* ldsl = (LAS unsigned char*)lds;
    __builtin_assume(__builtin_amdgcn_workitem_id_y() == 0); __builtin_assume(__builtin_amdgcn_workitem_id_z() == 0);
    const int wave = __builtin_amdgcn_readfirstlane(threadIdx.x >> 6);
    const int G = gridDim.x; int bx = blockIdx.x;
#define PHASE_TID() int tid = threadIdx.x; asm volatile("" : "+v"(tid)); const int lane = tid & 63; (void)lane
    int vcu = (G % 8 == 0) ? (bx % 8) * (G / 8) + bx / 8 : bx;
    int gw = vcu * 8 + wave; const int NGW = G * 8;
    bool xloc = false;
#define AS4 __attribute__((address_space(4)))
#define PHASE_ARGS() const Args AS4* KA_ = (const Args AS4*)__builtin_amdgcn_kernarg_segment_ptr(); asm volatile("" : "+s"(KA_)); unsigned char* const ws = KA_->ws; (void)ws
#define INP(i) (KA_->in[i])
#define WSP(TY, off) ((TY*)(ws + (off)))
    const int lo = args.ph_lo, hi = args.ph_hi;
#define IN(k) (lo <= (k) && (k) < hi)
#if MK_CG
#define SEAM(k) do { if (IN(k) && IN((k) + 1)) { cg::this_grid().sync(); } } while (0)
#define SEAM_L(k) SEAM(k)
#else
    volatile LAS unsigned* bst = (volatile LAS unsigned*)(ldsl + LDS_BYTES - 64);
    if (threadIdx.x < 4) bst[threadIdx.x] = 0u;
    __syncthreads();
    XcdBarrier xbar;
    { unsigned* barw = (unsigned*)(args.ws + WS_CTL) + 4096; xbar = xcd_barrier_post(barw, bst); }
#define SEAM(k) do { if (IN(k) && IN((k) + 1)) { xcd_barrier(xbar); } } while (0)
#define SEAM_L(k) do { if (IN(k) && IN((k) + 1)) { if (xloc) xcd_barrier_local(xbar); else xcd_barrier(xbar); } } while (0)
#endif

    if (IN(0)) REPS(0) {
        PHASE_TID(); PHASE_ARGS();
        const float* x = INP(0); const float* g_attn = INP(1); const float* w_in = INP(2); const float* g_q_lat = INP(4); const float* w_q_up = INP(5); const float* g_kv_lat = INP(6); const float* w_kv_up = INP(7);
        const float* w_mla_br = INP(12); const float* w_gqa_br = INP(13); const float* w_out = INP(14);
        bf16_t* Win_t = WSP(bf16_t, WS_WIN); bf16_t* Wqup_t = WSP(bf16_t, WS_WQUP); bf16_t* Wkvup_t = WSP(bf16_t, WS_WKVUP); bf16_t* Wa_t = WSP(bf16_t, WS_WA); bf16_t* Wb_t = WSP(bf16_t, WS_WB); bf16_t* Wo_t = WSP(bf16_t, WS_WO);
        bf16_t* XB = WSP(bf16_t, WS_XB); float* RINV1 = WSP(float, WS_RINV1);
        LAS float* scr = (LAS float*)(ldsl + wave * 16384);
        constexpr int I_IN = 16 * 121, I_QUP = 12 * 24, I_KVUP = 4 * 32, I_BR = 8 * 32, I_O = 16 * 32;
        constexpr int NITEMS = I_IN + I_QUP + I_KVUP + 2 * I_BR + I_O;
        for (int it = gw; it < NITEMS; it += NGW) {
            int r = it;
            if (r < I_IN) { const int kb = r / 121, nb = r % 121; tr_item_f8(w_in, 1024, 3872, kb * 64, nb * 32, (unsigned char*)Win_t, win_prow(nb * 32), g_attn, 32.f, scr, lane); continue; } r -= I_IN;
            if (r < I_QUP) { const int kb = r / 24, nb = r % 24; tr_item(w_q_up, 768, 768, kb * 64, nb * 32, Wqup_t, nb * 32, g_q_lat, scr, lane); continue; } r -= I_QUP;
            if (r < I_KVUP) { const int kb = r / 32, nb = r % 32; tr_item(w_kv_up, 256, 1024, kb * 64, nb * 32, Wkvup_t, ((nb >> 3) * 256) + ((nb & 1) * 128) + 32 * (2 * ((nb >> 2) & 1) + ((nb >> 1) & 1)), g_kv_lat, scr, lane);     continue; } r -= I_KVUP;
            if (r < I_BR) { const int kb = r / 32, nb = r % 32; tr_item_f8(w_mla_br, 1024, 1024, kb * 64, nb * 32, (unsigned char*)Wa_t, nb * 32, nullptr, 32.f, scr, lane); continue; } r -= I_BR;
            if (r < I_BR) { const int kb = r / 32, nb = r % 32; tr_item_f8(w_gqa_br, 1024, 1024, kb * 64, nb * 32, (unsigned char*)Wa_t + 512, nb * 32, nullptr, 32.f, scr, lane); continue; } r -= I_BR;
            { const int kb = r / 32, nb = r % 32; tr_item_f8(w_out, 1024, 1024, kb * 64, nb * 32, (unsigned char*)Wo_t, nb * 32, nullptr, 32.f, scr, lane); }
        }
        for (int i = gw * 64 + lane; i < 64 * 16 + 64 * 8; i += NGW * 64) {
            const bool big = i < 1024; const int j = big ? i : i - 1024, pos = big ? (j >> 4) : (j >> 3), f = big ? (j & 15) : (j & 7);
            float sn, cs; rope_cs((float)pos, f, big ? 0.0625f : 0.125f, sn, cs);
            float* tp = (big ? WSP(float, WS_ROPE16) : WSP(float, WS_ROPE8)) + 2 * j; tp[0] = cs; tp[1] = sn; }
        for (int i = gw * 64 + lane; i < 224 * 64; i += NGW * 64) *(u32x4*)((unsigned char*)Win_t + (size_t)1056 * 1024 + (size_t)i * 16) = (u32x4){0u, 0u, 0u, 0u};
        for (int m0 = gw * 4; m0 < T; m0 += NGW * 4) {
            f32x4 v[4][4];
#pragma unroll
            for (int r = 0; r < 4; ++r) { const f32x4* xr = (const f32x4*)(x + (size_t)(m0 + r) * DM) + lane;
#pragma unroll
                for (int j = 0; j < 4; ++j) v[r][j] = xr[64 * j]; }
#pragma unroll
            for (int r = 0; r < 4; ++r) { float s_ = 0.f;
#pragma unroll
                for (int j = 0; j < 4; ++j) s_ += (v[r][j][0] * v[r][j][0] + v[r][j][1] * v[r][j][1]) + (v[r][j][2] * v[r][j][2] + v[r][j][3] * v[r][j][3]);
                s_ = wave_sum(s_);
                if (lane == 0) RINV1[m0 + r] = 1.0f / sqrtf(s_ * (1.0f / DM) + EPS);
                unsigned* o4 = (unsigned*)((unsigned char*)XB + (size_t)(m0 + r) * DM) + lane;
#pragma unroll
                for (int j = 0; j < 4; ++j) { int t = __builtin_amdgcn_cvt_pk_fp8_f32(v[r][j][0], v[r][j][1], 0, false); t = __builtin_amdgcn_cvt_pk_fp8_f32(v[r][j][2], v[r][j][3], t, true); o4[64 * j] = (unsigned)t; } }
        }
        __syncthreads();
    }
    SEAM(0);
#if !MK_CG
    if (IN(0) && IN(1)) {
        const unsigned uni = __builtin_amdgcn_readfirstlane(bst[3]), rk = __builtin_amdgcn_readfirstlane(bst[2]);
        if (uni != 0u && rk < 32u && xbar.x < 8u) { xloc = true; bx = (int)(rk * 8u + xbar.x); vcu = (bx % 8) * (G / 8) + bx / 8; gw = vcu * 8 + wave; }
    }
#endif
    if (IN(1)) REPS(1) {
        PHASE_ARGS();
        pg8::Gemm g{WSP(bf16_t, WS_XB), WSP(bf16_t, WS_WIN), nullptr}; pg8::TileOrder<T, 4096, 0> S; S.init(G, bx);
        pg8::EpiProj E{WSP(float, WS_RINV1), WSP(bf16_t, WS_LAT), WSP(float, WS_SSQ), WSP(bf16_t, WS_QB), WSP(bf16_t, WS_KB), WSP(bf16_t, WS_VB), WSP(unsigned char, WS_GATES), INP(3), INP(11), WSP(float, WS_ROPE16)};
        pg8::gemm_phase<1024, 1024, false, 1>(ldsl, g, S, E);
    }
    SEAM_L(1);
    if (IN(2)) REPS(2) {
        { PHASE_ARGS(); pg8::Gemm g{WSP(bf16_t, WS_LAT), WSP(bf16_t, WS_WQUP), nullptr}; pg8::TileOrder<T, 768, 0> S; S.init(G, bx); pg8::EpiQup E{WSP(float, WS_SSQ), WSP(bf16_t, WS_QA)}; pg8::gemm_phase<QL, LATW>(ldsl, g, S, E); }
        { PHASE_ARGS(); pg8::Gemm g{WSP(bf16_t, WS_LAT) + QL, WSP(bf16_t, WS_WKVUP), nullptr}; pg8::TileOrder<T, 1024, 0> S; S.init(G, bx); pg8::EpiKVup E{WSP(float, WS_SSQ), WSP(bf16_t, WS_LAT), INP(9), WSP(float, WS_ROPE8), WSP(bf16_t, WS_KA), WSP(bf16_t, WS_VA)}; pg8::gemm_phase<KVL, LATW>(ldsl, g, S, E); }
    }
    SEAM_L(2);
#define EXPERT_ITEM(it_, scr_) do { const int mtx_ = (it_) >> 8, r_ = (it_) & 255, kb_ = r_ >> 4, nb_ = r_ & 15, e_ = mtx_ & 15, kind_ = mtx_ >> 4, n0_ = nb_ * 64; \
        if (kind_ == 0)      tr_item64_f8(INP(18) + (size_t)e_ * DM * FF, 1024, 1024, kb_ * 64, n0_, WSP(unsigned char, WS_WGU) + (size_t)e_ * 2048 * 1024, (n0_ >> 7) * 256 + (n0_ & 127), INP(15), 64.f, scr_, lane); \
        else if (kind_ == 1) tr_item64_f8(INP(19) + (size_t)e_ * DM * FF, 1024, 1024, kb_ * 64, n0_, WSP(unsigned char, WS_WGU) + (size_t)e_ * 2048 * 1024, (n0_ >> 7) * 256 + 128 + (n0_ & 127), INP(15), 64.f, scr_, lane); \
        else                 tr_item64_f8(INP(20) + (size_t)e_ * FF * DM, 1024, 1024, kb_ * 64, n0_, WSP(unsigned char, WS_WD) + (size_t)e_ * 1024 * 1024, n0_, nullptr, 64.f, scr_, lane); } while (0)
    if (IN(4)) REPS(4) {
        PHASE_ARGS();
        const bf16_t* Qa = WSP(bf16_t, WS_QA); const bf16_t* Ka = WSP(bf16_t, WS_KA); const bf16_t* Va = WSP(bf16_t, WS_VA); const bf16_t* Qb = WSP(bf16_t, WS_QB); const bf16_t* Kb = WSP(bf16_t, WS_KB); const bf16_t* Vb = WSP(bf16_t, WS_VB); unsigned char* Y8 = WSP(unsigned char, WS_XB);
        float mref96, mref64;
        { PHASE_TID(); const float* gq = INP(8); const float* gk = INP(9); const float* hq = INP(10); const float* hk = INP(11);
          float a = fmaxf(fabsf(gq[lane]), (lane < 32) ? fabsf(gq[64 + lane]) : 0.f), b = fmaxf(fabsf(gk[lane]), (lane < 32) ? fabsf(gk[64 + lane]) : 0.f), c = fabsf(hq[lane]), d = fabsf(hk[lane]);
#pragma unroll
          for (int o = 1; o < 64; o <<= 1) { a = fmaxf(a, __shfl_xor(a, o)); b = fmaxf(b, __shfl_xor(b, o)); c = fmaxf(c, __shfl_xor(c, o)); d = fmaxf(d, __shfl_xor(d, o)); }
          mref96 = __builtin_amdgcn_readfirstlane(__float_as_uint(1.02f * 9.797958971f * 1.4426950409f * a * b)); mref96 = __uint_as_float(__builtin_amdgcn_readfirstlane(__float_as_uint(1.02f * 9.797958971f * 1.4426950409f * a * b)));
          mref64 = __uint_as_float(__builtin_amdgcn_readfirstlane(__float_as_uint(1.02f * 8.0f * 1.4426950409f * c * d))); }
        const bool fast96 = mref96 <= 60.f, fast64 = mref64 <= 60.f;
#define ATT_MLA(bh_, qb_) do { const int b_ = (bh_) >> 3, h_ = (bh_) & 7; const bf16_t* q_ = Qa + ((size_t)(bh_) * SEQ + (qb_) * 256) * 96; const unsigned char* k_ = (const unsigned char*)Ka + (size_t)(bh_) * SEQ * 96; \
        const bf16_t* v_ = Va + (size_t)(bh_) * SEQ * 64; unsigned char* o_ = Y8 + ((size_t)b_ * SEQ + (qb_) * 256) * DM + h_ * 64; \
        if (fast96) att::attn_unit4<96, 1024, false>(q_, k_, v_, o_, SEQ, (LAS char*)ldsl, 0.f, INP(8), WSP(float, WS_ROPE8), (qb_) * 256); \
        else att::attn_unit4<96, 1024, true>(q_, k_, v_, o_, SEQ, (LAS char*)ldsl, -mref96, INP(8), WSP(float, WS_ROPE8), (qb_) * 256); } while (0)
#define ATT_GQA(bh_, qb_) do { const int b_ = (bh_) >> 3, h_ = (bh_) & 7, kvh_ = h_ >> 2; const bf16_t* q_ = Qb + ((size_t)(bh_) * SEQ + (qb_) * 256) * 64; const unsigned char* k_ = (const unsigned char*)Kb + (size_t)(b_ * 2 + kvh_) * SEQ * 64; \
        const bf16_t* v_ = Vb + (size_t)(b_ * 2 + kvh_) * SEQ * 64; unsigned char* o_ = Y8 + ((size_t)b_ * SEQ + (qb_) * 256) * DM + 512 + h_ * 64; \
        if (fast64) att::attn_unit4<64, 1024, false>(q_, k_, v_, o_, SEQ, (LAS char*)ldsl, 0.f, INP(10), WSP(float, WS_ROPE16), (qb_) * 256); \
        else att::attn_unit4<64, 1024, true>(q_, k_, v_, o_, SEQ, (LAS char*)ldsl, -mref64, INP(10), WSP(float, WS_ROPE16), (qb_) * 256); } while (0)
        if (G == 256) {
            const int xcd = bx % 8, v = bx / 8, slot = v >> 4, qb = v & 15;
            for (int r = 0; r < 4; ++r) { ATT_MLA(xcd * 8 + 2 * r + slot, qb);
                { PHASE_TID(); EXPERT_ITEM(r * 2048 + gw, (LAS float*)(ldsl + wave * 16640)); __syncthreads(); } }
            for (int r = 0; r < 4; ++r) { ATT_GQA(xcd * 8 + 2 * r + slot, qb);
                if (r < 2) { PHASE_TID(); EXPERT_ITEM((4 + r) * 2048 + gw, (LAS float*)(ldsl + wave * 16640)); __syncthreads(); } }
        } else {
            for (int uix = bx; uix < 2048; uix += G) { const int r = uix & 1023; if (uix < 1024) ATT_MLA(r >> 4, r & 15); else ATT_GQA(r >> 4, r & 15); }
        }
#undef ATT_MLA
#undef ATT_GQA
    }
    SEAM_L(4);
    if (IN(5)) REPS(5) {
        PHASE_ARGS(); pg8::Gemm g{WSP(bf16_t, WS_XB), WSP(bf16_t, WS_WA), nullptr}; pg8::TileOrder<T, 1024, 0> S; S.init(G, bx); pg8::EpiMerge2 E{WSP(unsigned char, WS_GATES), WSP(unsigned char, WS_MG)};
        pg8::gemm_phase<1024, 1024, false, 1>(ldsl, g, S, E);
    }
    SEAM_L(5);
    if (IN(6)) REPS(6) {
        PHASE_ARGS();
        pg8::Gemm g{WSP(bf16_t, WS_MG), WSP(bf16_t, WS_WO), nullptr}; pg8::TileOrder<T, 1024, 0> S; S.init(G, bx); pg8::EpiOut E{INP(0), WSP(bf16_t, WS_X1H), WSP(unsigned char, WS_XB)};
        pg8::gemm_phase<1024, 1024, false, 1>(ldsl, g, S, E);
    }
    SEAM_L(6);
    if (IN(7)) REPS(7) {
        PHASE_TID(); PHASE_ARGS();
        const float* g_ffn = INP(15); const float* w_router = INP(16); const float* b_router = INP(17); const bf16_t* x1h = WSP(bf16_t, WS_X1H); float* AFF = WSP(float, WS_AFF); float* RINV2 = WSP(float, WS_RINV2);
        LAS float* WR = (LAS float*)ldsl;
        for (int i = tid; i < 1024 * 16; i += 512) { const int k = i >> 4, e = i & 15, rho = (k & ~31) | ((k & 7) << 2) | ((k >> 3) & 3); WR[rho * 16 + e] = g_ffn[k] * w_router[i]; }
        __syncthreads();
        const int li = lane & 15, kq = lane >> 4;
        const float be = b_router[li];
        for (int tile = gw; tile < T / 16; tile += NGW) {
            const int row0 = tile * 16;
            const u32x4* xp = (const u32x4*)(x1h + (size_t)(row0 + li) * DM) + kq;
            f32x4 acc = {0.f, 0.f, 0.f, 0.f}; float ss = 0.f;
            const LAS float* wl = WR + kq * 16 + li;
            u32x4 xa[8], xb[8];
#pragma unroll
            for (int q = 0; q < 8; ++q) xa[q] = xp[4 * q];
#pragma unroll 1
            for (int c = 0; c < 4; c += 2) {
#pragma unroll
                for (int q = 0; q < 8; ++q) xb[q] = xp[4 * ((c + 1) * 8 + q)];
#pragma unroll
                for (int q = 0; q < 8; ++q) { const int j = c * 8 + q; f32x4 f0, f1; unpack8_f16(xa[q], f0, f1);
#pragma unroll
                    for (int t = 0; t < 8; ++t) { const float a = (t < 4) ? f0[t & 3] : f1[t & 3]; ss += a * a; acc = __builtin_amdgcn_mfma_f32_16x16x4f32(a, wl[(32 * j + 4 * t) * 16], acc, 0, 0, 0); } }
                if (c + 2 < 4) {
#pragma unroll
                    for (int q = 0; q < 8; ++q) xa[q] = xp[4 * ((c + 2) * 8 + q)]; }
#pragma unroll
                for (int q = 0; q < 8; ++q) { const int j = (c + 1) * 8 + q; f32x4 f0, f1; unpack8_f16(xb[q], f0, f1);
#pragma unroll
                    for (int t = 0; t < 8; ++t) { const float a = (t < 4) ? f0[t & 3] : f1[t & 3]; ss += a * a; acc = __builtin_amdgcn_mfma_f32_16x16x4f32(a, wl[(32 * j + 4 * t) * 16], acc, 0, 0, 0); } }
            }
            ss += __shfl_xor(ss, 16); ss += __shfl_xor(ss, 32);
            const float ri = 1.0f / sqrtf(ss * (1.0f / DM) + EPS);
            if (kq == 0) RINV2[row0 + li] = ri;
#pragma unroll
            for (int r = 0; r < 4; ++r) {
                const int R = 4 * kq + r; const float rr = __shfl(ri, R);
                const float lg = acc[r] * rr + be;
                float mx = lg;
#pragma unroll
                for (int o = 1; o < 16; o <<= 1) mx = fmaxf(mx, __shfl_xor(mx, o));
                const float ex = __expf(lg - mx); float den = ex;
#pragma unroll
                for (int o = 1; o < 16; o <<= 1) den += __shfl_xor(den, o);
                const int m = row0 + R, b = m >> 12, s_ = m & 4095;
                AFF[((size_t)(b * 16 + li)) * SEQ + s_] = ex / den;
            }
        }
        __syncthreads();
    }
    SEAM_L(7);
    if (IN(8)) REPS(8) {
        PHASE_TID(); PHASE_ARGS();
        const float* AFF = WSP(float, WS_AFF); const float* RINV2 = WSP(float, WS_RINV2); int* IDX = WSP(int, WS_IDX); float* GATEV = WSP(float, WS_GATEV); float* RG = WSP(float, WS_RG); int* INV = WSP(int, WS_INV);
        for (int p0_ = bx; p0_ < BATCH * NEXP; p0_ += G) {
            const int p = (G == 256) ? (p0_ % 8) * 16 + p0_ / 8 : p0_;
            LAS unsigned* keys = (LAS unsigned*)ldsl;
            LAS int* hist = (LAS int*)(ldsl + 16384);
            LAS int* scr = (LAS int*)(ldsl + 16384 + 1024);
            const int b = p >> 4, e = p & 15;
            const unsigned* ap = (const unsigned*)(AFF + (size_t)p * SEQ);
            for (int i = tid; i < SEQ; i += 512) keys[i] = ap[i];
            __syncthreads();
            unsigned prefix = 0u, pmask = 0u; int want = CAP;
            for (int pass = 0; pass < 4; ++pass) {
                const int shift = 24 - 8 * pass;
                if (tid < 256) hist[tid] = 0;
                __syncthreads();
                for (int i = tid; i < SEQ; i += 512) { const unsigned k = keys[i]; if ((k & pmask) == prefix) atomicAdd((int*)&hist[(k >> shift) & 255u], 1); }
                __syncthreads();
                if (tid < 64) {
                    const int c0 = hist[255 - 4 * tid], c1 = hist[254 - 4 * tid], c2 = hist[253 - 4 * tid], c3 = hist[252 - 4 * tid]; const int sm = (c0 + c1) + (c2 + c3);
                    int inc = sm;
#pragma unroll
                    for (int o = 1; o < 64; o <<= 1) { const int y = __shfl_up(inc, o); if (tid >= o) inc += y; }
                    const int exc = inc - sm;
                    if (exc < want && want <= inc) { int cum = exc, d = 255 - 4 * tid;
                        if (cum + c0 < want) { cum += c0; --d; if (cum + c1 < want) { cum += c1; --d; if (cum + c2 < want) { cum += c2; --d; } } }
                        scr[16] = d; scr[17] = want - cum; }
                }
                __syncthreads();
                const int d = scr[16]; want = scr[17];
                prefix |= ((unsigned)d) << shift; pmask |= 255u << shift;
                __syncthreads();
            }
            const unsigned thr = prefix; const int need_eq = want;
            unsigned kv[8]; int ceq = 0;
#pragma unroll
            for (int j = 0; j < 8; ++j) { kv[j] = keys[tid * 8 + j]; ceq += (kv[j] == thr) ? 1 : 0; }
            int toteq; int eqbase = block_scan(ceq, toteq, scr, tid);
            int csel = 0; unsigned selmask = 0u;
#pragma unroll
            for (int j = 0; j < 8; ++j) { bool sel = kv[j] > thr; if (kv[j] == thr) { sel = eqbase < need_eq; ++eqbase; } if (sel) { selmask |= 1u << j; ++csel; } }
            int totsel; int slot = block_scan(csel, totsel, scr, tid);
#pragma unroll
            for (int j = 0; j < 8; ++j) { const int s = tid * 8 + j; int iv = -1;
                if (selmask & (1u << j)) { iv = slot; IDX[(e * 8 + b) * CAP + slot] = b * SEQ + s; GATEV[(size_t)(e * 8 + b) * CAP + slot] = __uint_as_float(kv[j]); RG[(size_t)(e * 8 + b) * CAP + slot] = RINV2[b * SEQ + s]; ++slot; }
                INV[((size_t)b * SEQ + s) * 16 + e] = iv; }
            __syncthreads();
        }
        if (G != 256) { LAS float* scr = (LAS float*)(ldsl + wave * 16640);
          for (int it = gw; it < 48 * 256; it += NGW) EXPERT_ITEM(it, scr); }
        __syncthreads();
    }
    SEAM(8);
    if (IN(10)) REPS(10) {
        PHASE_ARGS();
        pg8::Gemm g{WSP(bf16_t, WS_XB), WSP(bf16_t, WS_WGU), WSP(int, WS_IDX)};
        pg8::TileOrder<NEXP * BATCH * CAP, 2048, 16> S; S.init(G, bx); pg8::EpiSwiGLU E{WSP(float, WS_RG), WSP(unsigned char, WS_ACT)};
        pg8::gemm_phase<1024, 1024, true, 1>(ldsl, g, S, E);
    }
    SEAM_L(10);
    if (IN(11)) REPS(11) {
        PHASE_ARGS();
        pg8::Gemm g{WSP(bf16_t, WS_ACT), WSP(bf16_t, WS_WD), nullptr}; pg8::TileOrder<NEXP * BATCH * CAP, 1024, 16> S; S.init(G, bx); pg8::EpiDown E{WSP(float, WS_GATEV), WSP(unsigned char, WS_XE)};
        pg8::gemm_phase<1024, 1024, false, 1>(ldsl, g, S, E);
    }
    SEAM(11);
    if (IN(12)) REPS(12) {
        PHASE_TID(); PHASE_ARGS();
        const int* INV = WSP(int, WS_INV); const unsigned char* YE = WSP(unsigned char, WS_XE); float* out = KA_->out; const bf16_t* x1h = WSP(bf16_t, WS_X1H);
        for (int m0 = gw * 2; m0 < T; m0 += NGW * 2) {
            const int b = m0 >> 12;
            int myinv[2]; f32x4 ac[2][4]; unsigned long long mask[2];
#pragma unroll
            for (int r = 0; r < 2; ++r) { const int m = m0 + r; myinv[r] = (lane < 16) ? INV[(size_t)m * 16 + lane] : -1; const bf16_t* xrow = x1h + (size_t)m * DM;
                unpack8_f16(*(const u32x4*)(xrow + lane * 8), ac[r][0], ac[r][1]); unpack8_f16(*(const u32x4*)(xrow + 512 + lane * 8), ac[r][2], ac[r][3]); }
#pragma unroll
            for (int r = 0; r < 2; ++r) mask[r] = __ballot(myinv[r] >= 0);
            while (mask[0] | mask[1]) {
                u32x2 y[2][2][2]; int cnt[2] = {0, 0};
#pragma unroll
                for (int r = 0; r < 2; ++r)
#pragma unroll
                    for (int q = 0; q < 2; ++q) { if (mask[r]) { const int e = __builtin_ctzll(mask[r]); mask[r] &= mask[r] - 1; const int sl = __shfl(myinv[r], e);
                            const unsigned char* yr = YE + ((size_t)(e * 8 + b) * CAP + sl) * DM; y[r][q][0] = *(const u32x2*)(yr + lane * 8); y[r][q][1] = *(const u32x2*)(yr + 512 + lane * 8); cnt[r] = q + 1; } }
#pragma unroll
                for (int r = 0; r < 2; ++r)
#pragma unroll
                    for (int q = 0; q < 2; ++q) { if (q < cnt[r]) { f32x4 y0, y1, y2, y3; unpack8_fp8(y[r][q][0], y0, y1); unpack8_fp8(y[r][q][1], y2, y3);
                            ac[r][0] += y0 * 0.015625f; ac[r][1] += y1 * 0.015625f; ac[r][2] += y2 * 0.015625f; ac[r][3] += y3 * 0.015625f; } }
            }
#pragma unroll
            for (int r = 0; r < 2; ++r) { float* orow = out + (size_t)(m0 + r) * DM;
                if (PROBE_PH == 12 && rp_ + 1 < PROBE_REPS) orow = WSP(float, WS_ACT) + (size_t)(m0 + r) * DM;
                *(f32x4*)(orow + lane * 8) = ac[r][0]; *(f32x4*)(orow + lane * 8 + 4) = ac[r][1]; *(f32x4*)(orow + 512 + lane * 8) = ac[r][2]; *(f32x4*)(orow + 512 + lane * 8 + 4) = ac[r][3]; }
        }
    }
#undef IN
#undef SEAM
#undef SEAM_L
}


extern "C" void kernel_launch(void* const* d_in, const int* in_sizes, int n_in, void* d_out, int out_size, void* d_ws, size_t ws_size, hipStream_t stream) {
    static int grid = 0;
    if (grid == 0) {
        if (n_in != 21 || in_sizes[0] != T * DM || out_size != T * DM || ws_size < WS_END) {
            fprintf(stderr, "kernel_launch: unexpected shapes: n_in %d in0 %d out %d ws %zu (need >= %zu)\n", n_in, n_in > 0 ? in_sizes[0] : -1, out_size, ws_size, (size_t)WS_END); grid = -1; return; }
        int dev = 0, cus = 0, per_cu = 0;
        if (hipGetDevice(&dev) != hipSuccess || hipDeviceGetAttribute(&cus, hipDeviceAttributeMultiprocessorCount, dev) != hipSuccess) { grid = -1; return; }
        if (hipFuncSetAttribute((const void*)fwd_kernel, hipFuncAttributeMaxDynamicSharedMemorySize, LDS_BYTES) != hipSuccess) { fprintf(stderr, "kernel_launch: hipFuncSetAttribute failed\n"); grid = -1; return; }
        if (hipOccupancyMaxActiveBlocksPerMultiprocessor(&per_cu, (const void*)fwd_kernel, 512, LDS_BYTES) != hipSuccess || per_cu < 1) { fprintf(stderr, "kernel_launch: occupancy query gave %d\n", per_cu); per_cu = 1; }
        (void)hipGetLastError();
        grid = cus;
    }
    if (grid < 0) return;
    Args a{};
    for (int i = 0; i < 21; ++i) a.in[i] = (const float*)d_in[i];
    a.out = (float*)d_out; a.ws = (unsigned char*)d_ws;
#if MK_MULTI
    for (int p = 0; p < NPH; ++p) { a.ph_lo = p; a.ph_hi = p + 1; hipLaunchKernelGGL(fwd_kernel, dim3(grid), dim3(512), LDS_BYTES, stream, a); }
#elif MK_CG
    a.ph_lo = 0; a.ph_hi = NPH;
    void* kargs[] = {&a};
    hipError_t e = hipLaunchCooperativeKernel((const void*)fwd_kernel, dim3(grid), dim3(512), kargs, LDS_BYTES, stream);
    if (e != hipSuccess) fprintf(stderr, "kernel_launch: cooperative launch failed: %s (grid %d)\n", hipGetErrorString(e), grid);
#else
    a.ph_lo = 0; a.ph_hi = NPH;
    if (hipMemsetAsync((char*)d_ws + WS_CTL, 0, CTL_ZERO_BYTES, stream) != hipSuccess) { fprintf(stderr, "kernel_launch: memset of the barrier words failed\n"); return; }
    hipLaunchKernelGGL(fwd_kernel, dim3(grid), dim3(512), LDS_BYTES, stream, a);
#endif
}
```

```cpp
#include <hip/hip_runtime.h>
#include <hip/hip_bf16.h>
#include <hip/hip_cooperative_groups.h>
#include <cstdio>
#include <cstdint>
namespace cg = cooperative_groups;

#ifndef MK_CG
#define MK_CG 0
#endif
#ifndef PROBE_PH
#define PROBE_PH -1
#define PROBE_REPS 1
#endif
#define REPS(k) for (int rp_ = 0; rp_ < ((k) == PROBE_PH ? PROBE_REPS : 1); ++rp_)
#ifndef MK_MULTI
#define MK_MULTI 0
#endif

constexpr int BATCH = 8, SEQ = 4096, DM = 1024, T = BATCH * SEQ;
constexpr int QL = 768, KVL = 256, LATW = 1056;
constexpr int NEXP = 16, CAP = 512, FF = 1024;
constexpr float EPS = 1e-6f;
constexpr int NPH = 13;

#define LAS __attribute__((address_space(3)))
#define GAS __attribute__((address_space(1)))
typedef unsigned short bf16_t;
typedef short bf16x8 __attribute__((ext_vector_type(8)));
typedef float f32x4 __attribute__((ext_vector_type(4)));
typedef float f32x2 __attribute__((ext_vector_type(2)));
typedef float f32x16 __attribute__((ext_vector_type(16)));
typedef unsigned u32x4 __attribute__((ext_vector_type(4)));
typedef unsigned u32x2 __attribute__((ext_vector_type(2)));
typedef short s16x4 __attribute__((ext_vector_type(4)));

__device__ __forceinline__ unsigned cvt_pk_bf16(float lo, float hi) { unsigned r; asm volatile("v_cvt_pk_bf16_f32 %0, %1, %2" : "=v"(r) : "v"(lo), "v"(hi)); return r; }
__device__ __forceinline__ u32x4 pack8(f32x4 a, f32x4 b) { u32x4 w; w.x = cvt_pk_bf16(a[0], a[1]); w.y = cvt_pk_bf16(a[2], a[3]); w.z = cvt_pk_bf16(b[0], b[1]); w.w = cvt_pk_bf16(b[2], b[3]); return w; }
__device__ __forceinline__ float bf_lo(unsigned w) { return __uint_as_float(w << 16); }
__device__ __forceinline__ float bf_hi(unsigned w) { return __uint_as_float(w & 0xffff0000u); }
__device__ __forceinline__ void unpack8(u32x4 w, f32x4& a, f32x4& b) { a[0] = bf_lo(w.x); a[1] = bf_hi(w.x); a[2] = bf_lo(w.y); a[3] = bf_hi(w.y); b[0] = bf_lo(w.z); b[1] = bf_hi(w.z); b[2] = bf_lo(w.w); b[3] = bf_hi(w.w); }
__device__ __forceinline__ u32x2 pack8_fp8(f32x4 a, f32x4 b) { u32x2 w; int t = __builtin_amdgcn_cvt_pk_fp8_f32(a[0], a[1], 0, false); t = __builtin_amdgcn_cvt_pk_fp8_f32(a[2], a[3], t, true); w.x = (unsigned)t;
    t = __builtin_amdgcn_cvt_pk_fp8_f32(b[0], b[1], 0, false); t = __builtin_amdgcn_cvt_pk_fp8_f32(b[2], b[3], t, true); w.y = (unsigned)t; return w; }
__device__ __forceinline__ void unpack8_fp8(u32x2 w, f32x4& a, f32x4& b) {
    const f32x2 p0 = __builtin_amdgcn_cvt_pk_f32_fp8((int)w.x, false), p1 = __builtin_amdgcn_cvt_pk_f32_fp8((int)w.x, true), p2 = __builtin_amdgcn_cvt_pk_f32_fp8((int)w.y, false), p3 = __builtin_amdgcn_cvt_pk_f32_fp8((int)w.y, true);
    a[0] = p0[0]; a[1] = p0[1]; a[2] = p1[0]; a[3] = p1[1]; b[0] = p2[0]; b[1] = p2[1]; b[2] = p3[0]; b[3] = p3[1]; }
__device__ __forceinline__ int vt_pos(int s) { const int k = s & 15; return (s & ~15) | (((k >> 2) & 1) << 3) | ((k >> 3) << 2) | (k & 3); }
__device__ __forceinline__ void store_vt(bf16_t* vt, int d0, int s, f32x4 a0, f32x4 a1, f32x4 c0, f32x4 c1) {
    bf16_t* p = vt + (size_t)d0 * SEQ + vt_pos(s);
    const u32x4 wa = pack8(a0, a1), wc = pack8(c0, c1);
    p[0 * SEQ] = (bf16_t)(wa.x & 0xffffu); p[1 * SEQ] = (bf16_t)(wa.x >> 16); p[2 * SEQ] = (bf16_t)(wa.y & 0xffffu); p[3 * SEQ] = (bf16_t)(wa.y >> 16);
    p[4 * SEQ] = (bf16_t)(wa.z & 0xffffu); p[5 * SEQ] = (bf16_t)(wa.z >> 16); p[6 * SEQ] = (bf16_t)(wa.w & 0xffffu); p[7 * SEQ] = (bf16_t)(wa.w >> 16);
    p += (size_t)32 * SEQ;
    p[0 * SEQ] = (bf16_t)(wc.x & 0xffffu); p[1 * SEQ] = (bf16_t)(wc.x >> 16); p[2 * SEQ] = (bf16_t)(wc.y & 0xffffu); p[3 * SEQ] = (bf16_t)(wc.y >> 16);
    p[4 * SEQ] = (bf16_t)(wc.z & 0xffffu); p[5 * SEQ] = (bf16_t)(wc.z >> 16); p[6 * SEQ] = (bf16_t)(wc.w & 0xffffu); p[7 * SEQ] = (bf16_t)(wc.w >> 16);
}
typedef _Float16 h16x8 __attribute__((ext_vector_type(8)));
typedef float f32x8v __attribute__((ext_vector_type(8)));
__device__ __forceinline__ u32x4 pack8_f16(f32x4 a, f32x4 b) { const f32x8v v = {a[0], a[1], a[2], a[3], b[0], b[1], b[2], b[3]}; return __builtin_bit_cast(u32x4, __builtin_convertvector(v, h16x8)); }
__device__ __forceinline__ void unpack8_f16(u32x4 w, f32x4& a, f32x4& b) { const f32x8v v = __builtin_convertvector(__builtin_bit_cast(h16x8, w), f32x8v); a = (f32x4){v[0], v[1], v[2], v[3]}; b = (f32x4){v[4], v[5], v[6], v[7]}; }
__device__ __forceinline__ float sigmoidf_(float x) { return __builtin_amdgcn_rcpf(1.f + __builtin_amdgcn_exp2f(-1.4426950408889634f * x)); }

__device__ __forceinline__ void rope_cs(float pos, int fi, float nf_inv, float& s, float& c) {
    const float inv = __builtin_amdgcn_exp2f(-(float)fi * nf_inv * 13.287712379549449f);
    const float rev = pos * inv * 0.15915494309189535f; const float fr = rev - floorf(rev);
    s = __builtin_amdgcn_sinf(fr); c = __builtin_amdgcn_cosf(fr);
}
__device__ __forceinline__ f32x4 rope4t(f32x4 v, f32x4 cs) {
    f32x4 r; r[0] = v[0] * cs[0] - v[1] * cs[1]; r[1] = v[0] * cs[1] + v[1] * cs[0]; r[2] = v[2] * cs[2] - v[3] * cs[3]; r[3] = v[2] * cs[3] + v[3] * cs[2]; return r;
}
__device__ __forceinline__ f32x4 rope4(f32x4 v, float pos, int f0, float nf_inv) {
    float s0, c0, s1, c1; rope_cs(pos, f0, nf_inv, s0, c0); rope_cs(pos, f0 + 1, nf_inv, s1, c1);
    f32x4 r; r[0] = v[0] * c0 - v[1] * s0; r[1] = v[0] * s0 + v[1] * c0; r[2] = v[2] * c1 - v[3] * s1; r[3] = v[2] * s1 + v[3] * c1; return r;
}

namespace pg8 {
constexpr int BM = 256, BK = 64, HALF = 128, HTB = HALF * BK * 2, STAGE_BYTES = 8 * HTB, NXCD = 8, WGM = 8;
__host__ __device__ __forceinline__ int lds_byte(int r, int c) { const int st = (r >> 4) * 2 + (c >> 5), rr = r & 15, cc = c & 31, ob = rr * 64 + cc * 2; return st * 1024 + (ob ^ (((ob >> 9) & 1) << 5)); }
__host__ __device__ __forceinline__ void stage_rc(int b, int& R, int& C) { const int st = b / 1024, sb = b % 1024, swz = sb ^ (((sb >> 9) & 1) << 5); R = (st >> 1) * 16 + swz / 64; C = (st & 1) * 32 + (swz % 64) / 2; }
__host__ __device__ __forceinline__ int perm32(int rho) { const int n = rho >> 4, i = rho & 15; return 8 * (i >> 2) + 4 * n + (i & 3); }

struct Unit { int pm, pn, pb; };
struct Gemm { const bf16_t* A; const bf16_t* Bt; const int* rowmap; };

template <int M, int N, int BDIV, int FLIP = 0> struct TileOrder {
    static constexpr int nM = M / BM, nN = N / BM, nwg = nM * nN;
    int G, c;
    __device__ __forceinline__ void init(int G_, int c_) { G = G_; c = c_; }
    __device__ __forceinline__ bool next(int i, Unit& u) const {
        const int L = i * G + c; if (L >= nwg) return false;
        int wgid = L; { constexpr int q = nwg / NXCD, r = nwg % NXCD; const int xcd = wgid % NXCD, off = wgid / NXCD; wgid = (xcd < r ? xcd * (q + 1) : r * (q + 1) + (xcd - r) * q) + off; }
        constexpr int nig = WGM * nN; const int gid = wgid / nig, fm = gid * WGM, gsz = (nM - fm) < WGM ? (nM - fm) : WGM;
        u.pm = fm + ((wgid % nig) % gsz); u.pn = (wgid % nig) / gsz; if (FLIP && G == 256 && (i & 4)) u.pn ^= 3; u.pb = (BDIV ? (u.pm / (BDIV ? BDIV : 1)) * nN : 0) + u.pn; return true;
    }
};

typedef int v4i_t __attribute__((ext_vector_type(4)));
typedef int v8i_t __attribute__((ext_vector_type(8)));
template <int K, int LDA, bool GATHER = false, int ES = 2, class Epi, class Sched>
__device__ __forceinline__ void gemm_phase(LAS unsigned char* lds, const Gemm g, const Sched& S, const Epi& E) {
    int tid = threadIdx.x; asm volatile("" : "+v"(tid));
    const int wid = __builtin_amdgcn_readfirstlane(tid >> 6), lane = tid & 63, wr = wid >> 2, wc = wid & 3, fr = lane & 15, fq = lane >> 4;
    constexpr int nt = K * ES / (BK * 2), lda = LDA; static_assert((K * ES) % 256 == 0 && K * ES >= 512, "K bytes: multiple of 256, >= 512");
    unsigned voffA[2], voffB[2]; int gR[2]; unsigned gC[2];
#pragma unroll
    for (int i = 0; i < 2; ++i) { int R, C; stage_rc(tid * 16 + i * 8192, R, C); const int Rb = (R & ~31) + perm32(R & 31);
        voffA[i] = (unsigned)(R * lda * ES + C * 2); voffB[i] = (unsigned)(Rb * K * ES + C * 2); gR[i] = R; gC[i] = (unsigned)C * 2u; }
    unsigned cof[2][2], nof[2][2];
#define PG8_GOFF(dst, pm_) do { _Pragma("unroll") for (int h_ = 0; h_ < 2; ++h_) _Pragma("unroll") for (int i_ = 0; i_ < 2; ++i_) \
        dst[h_][i_] = (unsigned)g.rowmap[(pm_) * BM + h_ * HALF + gR[i_]] * (unsigned)(lda * ES) + gC[i_]; } while (0)
    constexpr size_t kstep = (size_t)(BK * 2);
    constexpr size_t hstepA = (size_t)HALF * lda * ES, hstepB = (size_t)HALF * K * ES;
    constexpr size_t tstepA = 2 * hstepA, tstepB = 2 * hstepB;
    const unsigned ldsw = (unsigned)wid * 1024u;
    const int aoff = lds_byte(wr * 64 + fr, fq * 8), boff = lds_byte(wc * 32 + fr, fq * 8);
#define PG8_SA(b, h) (((b) * 2 + (h)) * HTB)
#define PG8_SB(b, h) ((4 + (b) * 2 + (h)) * HTB)
#define PG8_STAGE(bufoff, gbase, voff) do { _Pragma("unroll") for (int _i = 0; _i < 2; ++_i) \
        __builtin_amdgcn_global_load_lds((const unsigned*)((const char*)(gbase) + (voff)[_i]), (LAS unsigned*)(lds + (bufoff) + ldsw + _i * 8192), 16, 0, 0); } while (0)
#define PG8_STAGE1(bufoff, gbase, voff0, rowbytes) do { _Pragma("unroll") for (int _i = 0; _i < 2; ++_i) \
        __builtin_amdgcn_global_load_lds((const unsigned*)((const char*)(gbase) + (size_t)_i * 64 * (rowbytes) + (voff0)), (LAS unsigned*)(lds + (bufoff) + ldsw + _i * 8192), 16, 0, 0); } while (0)
#define PG8_LDA(dst, b, h) do { _Pragma("unroll") for (int m = 0; m < 4; ++m) { \
        if constexpr (ES == 2) { _Pragma("unroll") for (int k = 0; k < 2; ++k) dst[m][k] = *(const LAS bf16x8*)(lds + PG8_SA(b, h) + aoff + m * 2048 + k * 1024); } \
        else { dst##8[m] = __builtin_shufflevector(*(const LAS v4i_t*)(lds + PG8_SA(b, h) + aoff + m * 2048), *(const LAS v4i_t*)(lds + PG8_SA(b, h) + aoff + m * 2048 + 1024), 0, 1, 2, 3, 4, 5, 6, 7); } } } while (0)
#define PG8_LDB(dst, b, h) do { _Pragma("unroll") for (int n = 0; n < 2; ++n) { \
        if constexpr (ES == 2) { _Pragma("unroll") for (int k = 0; k < 2; ++k) dst[n][k] = *(const LAS bf16x8*)(lds + PG8_SB(b, h) + boff + n * 2048 + k * 1024); } \
        else { dst##8[n] = __builtin_shufflevector(*(const LAS v4i_t*)(lds + PG8_SB(b, h) + boff + n * 2048), *(const LAS v4i_t*)(lds + PG8_SB(b, h) + boff + n * 2048 + 1024), 0, 1, 2, 3, 4, 5, 6, 7); } } } while (0)
#define PG8_MMA(ai, bj, At, Bt) do { __builtin_amdgcn_s_setprio(1); _Pragma("unroll") for (int m = 0; m < 4; ++m) _Pragma("unroll") for (int n = 0; n < 2; ++n) { \
        if constexpr (ES == 2) { _Pragma("unroll") for (int k = 0; k < 2; ++k) acc[ai][bj][m][n] = __builtin_amdgcn_mfma_f32_16x16x32_bf16(Bt[n][k], At[m][k], acc[ai][bj][m][n], 0, 0, 0); } \
        else { asm volatile("v_mfma_scale_f32_16x16x128_f8f6f4 %0, %1, %2, %0, %3, %3 op_sel_hi:[0,0,0]" : "+v"(acc[ai][bj][m][n]) : "v"(Bt##8[n]), "v"(At##8[m]), "v"(one_scale)); } } \
        __builtin_amdgcn_s_setprio(0); } while (0)
#define PG8_WAIT_V(n) asm volatile("s_waitcnt vmcnt(" #n ")" ::: "memory")
#define PG8_WAIT_L(n) asm volatile("s_waitcnt lgkmcnt(" #n ")" ::: "memory")
#define PG8_BAR __builtin_amdgcn_s_barrier()
#define PG8_SCHED __builtin_amdgcn_sched_barrier(0)
    Unit cur, nxt; int ui = 0;
    if (!S.next(0, cur)) return;
    f32x4 acc[2][2][4][2];
#pragma unroll
    for (int a = 0; a < 2; ++a)
#pragma unroll
        for (int b = 0; b < 2; ++b)
#pragma unroll
            for (int m = 0; m < 4; ++m)
#pragma unroll
                for (int n = 0; n < 2; ++n) acc[a][b][m][n] = (f32x4){0.f, 0.f, 0.f, 0.f};
    bf16x8 At[4][2], B0[2][2], B1[2][2]; v8i_t At8[4], B08[2], B18[2];
    const int one_scale = 0x7f7f7f7f;
    const char* cA = GATHER ? (const char*)g.A : (const char*)g.A + (size_t)cur.pm * tstepA; const char* cB = (const char*)g.Bt + (size_t)cur.pb * tstepB;
    if constexpr (GATHER) { PG8_GOFF(cof, cur.pm); }
    PG8_STAGE1(PG8_SB(0, 0), cB, voffB[0], K * ES); PG8_STAGE1(PG8_SB(0, 1), cB + hstepB, voffB[0], K * ES);
    if constexpr (GATHER) { PG8_STAGE(PG8_SA(0, 0), cA, cof[0]); PG8_STAGE(PG8_SA(0, 1), cA, cof[1]); } else { PG8_STAGE1(PG8_SA(0, 0), cA, voffA[0], lda * ES); PG8_STAGE1(PG8_SA(0, 1), cA + hstepA, voffA[0], lda * ES); }
    if (wr == 1) PG8_BAR;
    PG8_WAIT_V(2); PG8_BAR;
    PG8_STAGE1(PG8_SB(1, 0), cB + kstep, voffB[0], K * ES);
    if constexpr (GATHER) { PG8_STAGE(PG8_SA(1, 0), cA + kstep, cof[0]); } else { PG8_STAGE1(PG8_SA(1, 0), cA + kstep, voffA[0], lda * ES); }
    PG8_STAGE1(PG8_SB(1, 1), cB + hstepB + kstep, voffB[0], K * ES);
    PG8_WAIT_V(6); PG8_BAR;
    for (;;) {
        const bool has_next = S.next(ui + 1, nxt);
        const char* nA = GATHER ? cA : (has_next ? (const char*)g.A + (size_t)nxt.pm * tstepA : cA); const char* nB = has_next ? (const char*)g.Bt + (size_t)nxt.pb * tstepB : cB;
        if constexpr (GATHER) { if (has_next) { PG8_GOFF(nof, nxt.pm); } else {
#pragma unroll
            for (int h_ = 0; h_ < 2; ++h_) { nof[h_][0] = cof[h_][0]; nof[h_][1] = cof[h_][1]; } } }
#pragma unroll 1
        for (int t = 0; t < nt; t += 2) {
            const bool last = (t == nt - 2);
            const char* a1 = cA + (size_t)(t + 1) * kstep;
            const char* a2 = last ? nA : cA + (size_t)(t + 2) * kstep; const char* b2 = last ? nB : cB + (size_t)(t + 2) * kstep;
            const char* a3 = a2 + kstep; const char* b3 = b2 + kstep;
            unsigned sel0[2], sel1[2];
            if constexpr (GATHER) { sel0[0] = last ? nof[0][0] : cof[0][0]; sel0[1] = last ? nof[0][1] : cof[0][1]; sel1[0] = last ? nof[1][0] : cof[1][0]; sel1[1] = last ? nof[1][1] : cof[1][1]; }
            PG8_LDB(B0, 0, 0); PG8_LDB(B1, 0, 1); PG8_SCHED; PG8_LDA(At, 0, 0);
            if constexpr (GATHER) { PG8_STAGE(PG8_SA(1, 1), a1, cof[1]); } else { PG8_STAGE1(PG8_SA(1, 1), a1 + hstepA, voffA[0], lda * ES); }
            PG8_WAIT_V(8); PG8_WAIT_L(0); PG8_BAR; PG8_MMA(0, 0, At, B0); PG8_MMA(0, 1, At, B1); PG8_BAR; PG8_SCHED;
            PG8_LDA(At, 0, 1); PG8_STAGE1(PG8_SB(0, 0), b2, voffB[0], K * ES); PG8_STAGE1(PG8_SB(0, 1), b2 + hstepB, voffB[0], K * ES);
            if constexpr (GATHER) { PG8_STAGE(PG8_SA(0, 0), a2, sel0); } else { PG8_STAGE1(PG8_SA(0, 0), a2, voffA[0], lda * ES); }
            PG8_WAIT_V(8); PG8_WAIT_L(0); PG8_BAR; PG8_MMA(1, 0, At, B0); PG8_MMA(1, 1, At, B1); PG8_BAR; PG8_SCHED;
            PG8_LDB(B0, 1, 0); PG8_LDB(B1, 1, 1); PG8_SCHED; PG8_LDA(At, 1, 0);
            if constexpr (GATHER) { PG8_STAGE(PG8_SA(0, 1), a2, sel1); } else { PG8_STAGE1(PG8_SA(0, 1), a2 + hstepA, voffA[0], lda * ES); }
            PG8_WAIT_V(8); PG8_WAIT_L(0); PG8_BAR; PG8_MMA(0, 0, At, B0); PG8_MMA(0, 1, At, B1); PG8_BAR; PG8_SCHED;
            PG8_LDA(At, 1, 1); PG8_STAGE1(PG8_SB(1, 0), b3, voffB[0], K * ES); PG8_STAGE1(PG8_SB(1, 1), b3 + hstepB, voffB[0], K * ES);
            if constexpr (GATHER) { PG8_STAGE(PG8_SA(1, 0), a3, sel0); } else { PG8_STAGE1(PG8_SA(1, 0), a3, voffA[0], lda * ES); }
            PG8_WAIT_V(8); PG8_WAIT_L(0); PG8_BAR; PG8_MMA(1, 0, At, B0); PG8_MMA(1, 1, At, B1); PG8_BAR; PG8_SCHED;
            if constexpr (Epi::MIDT > 0) { if (t + 2 == Epi::MIDT) { if constexpr (ES == 1) asm volatile("s_nop 15\n\ts_nop 15" ::: "memory"); E.mid(acc, cur, wr, wc, fr, fq); if constexpr (ES == 1) asm volatile("s_nop 7" ::: "memory"); } }
        }
        if (wr == 0) PG8_BAR;
        if constexpr (ES == 1) asm volatile("s_nop 15\n\ts_nop 15" ::: "memory");
        E(acc, cur, wr, wc, fr, fq);
        if (!has_next) break;
#pragma unroll
        for (int a = 0; a < 2; ++a)
#pragma unroll
            for (int b = 0; b < 2; ++b)
#pragma unroll
                for (int m = 0; m < 4; ++m)
#pragma unroll
                    for (int n = 0; n < 2; ++n) acc[a][b][m][n] = (f32x4){0.f, 0.f, 0.f, 0.f};
        cur = nxt; cA = nA; cB = nB; ++ui;
        if constexpr (GATHER) {
#pragma unroll
            for (int h_ = 0; h_ < 2; ++h_) { cof[h_][0] = nof[h_][0]; cof[h_][1] = nof[h_][1]; } }
        if (wr == 1) PG8_BAR;
    }
    PG8_WAIT_V(0);
    PG8_BAR;
#undef PG8_GOFF
#undef PG8_SA
#undef PG8_SB
#undef PG8_STAGE
#undef PG8_STAGE1
#undef PG8_LDA
#undef PG8_LDB
#undef PG8_MMA
#undef PG8_WAIT_V
#undef PG8_WAIT_L
#undef PG8_BAR
#undef PG8_SCHED
}

#define EPI_ROWS_BEGIN  _Pragma("unroll") for (int ai = 0; ai < 2; ++ai) _Pragma("unroll") for (int m = 0; m < 4; ++m) { const int row = u.pm * BM + ai * HALF + wr * 64 + m * 16 + fr;
#define EPI_ROWS_END    if (m & 1) asm volatile("" ::: "memory"); }
#define EPI_ROWS_END4   if (m == 3) asm volatile("" ::: "memory"); }
#define EPI_COL(bj) ((bj) * HALF + wc * 32 + fq * 8)

struct EpiProj {
    static constexpr int MIDT = 0;
    const float* rinv1; bf16_t* LAT; float* SSQ; bf16_t* Qb; bf16_t* Kb; bf16_t* Vb; unsigned char* GATES; const float* b_gate; const float* gk; const float* T16;
    __device__ __forceinline__ void operator()(const f32x4 (&acc)[2][2][4][2], const Unit& u, int wr, int wc, int fr, int fq) const {
        const int pn = u.pn;
        if (pn >= 8) {
            f32x4 bv[2][2];
#pragma unroll
            for (int bj = 0; bj < 2; ++bj) { const int gc = (pn - 8) * BM + EPI_COL(bj); bv[bj][0] = *(const f32x4*)(b_gate + gc) * -1.4426950408889634f; bv[bj][1] = *(const f32x4*)(b_gate + gc + 4) * -1.4426950408889634f; }
            EPI_ROWS_BEGIN
                const float ri = rinv1[row] * (0.03125f * -1.4426950408889634f);
#pragma unroll
                for (int bj = 0; bj < 2; ++bj) { const int gc = (pn - 8) * BM + EPI_COL(bj);
                    f32x4 v0 = acc[ai][bj][m][0] * ri + bv[bj][0], v1 = acc[ai][bj][m][1] * ri + bv[bj][1];
#pragma unroll
                    for (int j = 0; j < 4; ++j) { v0[j] = __builtin_amdgcn_rcpf(fmaf(__builtin_amdgcn_exp2f(v0[j]), 0.00390625f, 0.00390625f)); v1[j] = __builtin_amdgcn_rcpf(fmaf(__builtin_amdgcn_exp2f(v1[j]), 0.00390625f, 0.00390625f)); }
                    *(u32x2*)(GATES + (size_t)row * 2048 + gc) = pack8_fp8(v0, v1); }
            EPI_ROWS_END
        } else if (pn < 4) {
            EPI_ROWS_BEGIN
                const float ri = rinv1[row] * 0.03125f; float ss = 0.f;
#pragma unroll
                for (int bj = 0; bj < 2; ++bj) { const f32x4 v0 = acc[ai][bj][m][0] * ri, v1 = acc[ai][bj][m][1] * ri;
                    ss += (v0[0] * v0[0] + v0[1] * v0[1]) + (v0[2] * v0[2] + v0[3] * v0[3]) + (v1[0] * v1[0] + v1[1] * v1[1]) + (v1[2] * v1[2] + v1[3] * v1[3]);
                    *(u32x4*)(LAT + (size_t)row * LATW + pn * BM + EPI_COL(bj)) = pack8(v0, v1); }
                ss += __shfl_xor(ss, 16); ss += __shfl_xor(ss, 32);
                if (fq == 0) SSQ[(size_t)row * 16 + pn * 4 + wc] = ss;
            EPI_ROWS_END
        } else if (pn == 4) {
            if (wc == 0) {
                EPI_ROWS_BEGIN
                    const float ri = rinv1[row] * 0.03125f;
                    *(u32x4*)(LAT + (size_t)row * LATW + 1024 + fq * 8) = pack8(acc[ai][0][m][0] * ri, acc[ai][0][m][1] * ri);
                EPI_ROWS_END
            }
        } else if (pn < 7) {
            EPI_ROWS_BEGIN
                const float ri = rinv1[row] * 0.03125f; const int b = row >> 12, s = row & 4095;
#pragma unroll
                for (int bj = 0; bj < 2; ++bj) { const int col = EPI_COL(bj), head = (pn - 5) * 4 + (col >> 6), d = col & 63;
                    *(u32x4*)(Qb + ((size_t)(b * 8 + head) * SEQ + s) * 64 + d) = pack8(acc[ai][bj][m][0] * ri, acc[ai][bj][m][1] * ri); }
            EPI_ROWS_END
        } else {
            if (wc < 2) {
                const f32x4 g00 = *(const f32x4*)(gk + 8 * fq), g01 = *(const f32x4*)(gk + 8 * fq + 4), g10 = *(const f32x4*)(gk + 32 + 8 * fq), g11 = *(const f32x4*)(gk + 32 + 8 * fq + 4);
                EPI_ROWS_BEGIN
                    const float ri = rinv1[row] * 0.03125f; const int b = row >> 12, s = row & 4095;
                    f32x4 a0 = acc[ai][0][m][0] * ri, a1 = acc[ai][0][m][1] * ri, c0 = acc[ai][1][m][0] * ri, c1 = acc[ai][1][m][1] * ri;
                    float ss = ((a0[0] * a0[0] + a0[1] * a0[1]) + (a0[2] * a0[2] + a0[3] * a0[3])) + ((a1[0] * a1[0] + a1[1] * a1[1]) + (a1[2] * a1[2] + a1[3] * a1[3]))
                             + ((c0[0] * c0[0] + c0[1] * c0[1]) + (c0[2] * c0[2] + c0[3] * c0[3])) + ((c1[0] * c1[0] + c1[1] * c1[1]) + (c1[2] * c1[2] + c1[3] * c1[3]));
                    ss += __shfl_xor(ss, 16); ss += __shfl_xor(ss, 32);
                    const float rn = 1.0f / sqrtf(ss * (1.0f / 64.f) + EPS);
                    a0 = a0 * rn * g00; a1 = a1 * rn * g01; c0 = c0 * rn * g10; c1 = c1 * rn * g11;
                    const float* tr = T16 + ((s >> 6) * 16 + 4 * fq) * 2; const float* tc = T16 + ((s & 63) * 16 + 4 * fq) * 2;
                    a0 = rope4t(a0, *(const f32x4*)tr); a1 = rope4t(a1, *(const f32x4*)(tr + 4)); c0 = rope4t(c0, *(const f32x4*)tc); c1 = rope4t(c1, *(const f32x4*)(tc + 4));
                    unsigned char* kp = (unsigned char*)Kb + ((size_t)(b * 2 + wc) * SEQ + s) * 64 + 8 * fq;
                    *(u32x2*)kp = pack8_fp8(a0, a1); *(u32x2*)(kp + 32) = pack8_fp8(c0, c1);
                    asm volatile("" ::: "memory");
                EPI_ROWS_END
            } else {
                EPI_ROWS_BEGIN
                    const float ri = rinv1[row] * 0.03125f; const int b = row >> 12, s = row & 4095;
                    store_vt(Vb + (size_t)(b * 2 + (wc - 2)) * 64 * SEQ, 8 * fq, s, acc[ai][0][m][0] * ri, acc[ai][0][m][1] * ri, acc[ai][1][m][0] * ri, acc[ai][1][m][1] * ri);
                EPI_ROWS_END
            }
        }
    }
};
struct EpiQup {
    static constexpr int MIDT = 0;
    const float* SSQ; bf16_t* Qa;
    __device__ __forceinline__ void operator()(const f32x4 (&acc)[2][2][4][2], const Unit& u, int wr, int wc, int fr, int fq) const {
        EPI_ROWS_BEGIN
            const f32x4* sp = (const f32x4*)(SSQ + (size_t)row * 16); const f32x4 s0 = sp[0], s1 = sp[1], s2 = sp[2];
            const float ss = ((s0[0] + s0[1]) + (s0[2] + s0[3])) + ((s1[0] + s1[1]) + (s1[2] + s1[3])) + ((s2[0] + s2[1]) + (s2[2] + s2[3]));
            const float ri = 1.0f / sqrtf(ss * (1.0f / QL) + EPS); const int b = row >> 12, s = row & 4095;
#pragma unroll
            for (int bj = 0; bj < 2; ++bj) { const int cg_ = u.pn * BM + EPI_COL(bj), h = cg_ / 96, d = cg_ - h * 96;
                *(u32x4*)(Qa + ((size_t)(b * 8 + h) * SEQ + s) * 96 + d) = pack8(acc[ai][bj][m][0] * ri, acc[ai][bj][m][1] * ri); }
        EPI_ROWS_END
    }
};
struct EpiKVup {
    static constexpr int MIDT = 0;
    const float* SSQ; const bf16_t* LAT; const float* gk; const float* T8; bf16_t* Ka; bf16_t* Va;
    __device__ __forceinline__ void operator()(const f32x4 (&acc)[2][2][4][2], const Unit& u, int wr, int wc, int fr, int fq) const {
        const int h = u.pn * 2 + (wc >> 1);
        if (wc & 1) {
            EPI_ROWS_BEGIN
                const f32x4 s3 = *(const f32x4*)(SSQ + (size_t)row * 16 + 12);
                const float ri = 1.0f / sqrtf(((s3[0] + s3[1]) + (s3[2] + s3[3])) * (1.0f / KVL) + EPS); const int b = row >> 12, s = row & 4095;
                store_vt(Va + (size_t)(b * 8 + h) * 64 * SEQ, 8 * fq, s, acc[ai][0][m][0] * ri, acc[ai][0][m][1] * ri, acc[ai][1][m][0] * ri, acc[ai][1][m][1] * ri);
            EPI_ROWS_END
        } else {
            const f32x4 g00 = *(const f32x4*)(gk + 8 * fq), g01 = *(const f32x4*)(gk + 8 * fq + 4), g10 = *(const f32x4*)(gk + 32 + 8 * fq), g11 = *(const f32x4*)(gk + 32 + 8 * fq + 4);
            const f32x4 gr0 = *(const f32x4*)(gk + 64 + 8 * fq), gr1 = *(const f32x4*)(gk + 64 + 8 * fq + 4);
            EPI_ROWS_BEGIN
                const f32x4 s3 = *(const f32x4*)(SSQ + (size_t)row * 16 + 12);
                const float ri = 1.0f / sqrtf(((s3[0] + s3[1]) + (s3[2] + s3[3])) * (1.0f / KVL) + EPS); const int b = row >> 12, s = row & 4095;
                f32x4 a0 = acc[ai][0][m][0] * ri, a1 = acc[ai][0][m][1] * ri, c0 = acc[ai][1][m][0] * ri, c1 = acc[ai][1][m][1] * ri, r0, r1;
                unpack8(*(const u32x4*)(LAT + (size_t)row * LATW + 1024 + 8 * fq), r0, r1);
                float ss = ((a0[0] * a0[0] + a0[1] * a0[1]) + (a0[2] * a0[2] + a0[3] * a0[3])) + ((a1[0] * a1[0] + a1[1] * a1[1]) + (a1[2] * a1[2] + a1[3] * a1[3]))
                         + ((c0[0] * c0[0] + c0[1] * c0[1]) + (c0[2] * c0[2] + c0[3] * c0[3])) + ((c1[0] * c1[0] + c1[1] * c1[1]) + (c1[2] * c1[2] + c1[3] * c1[3]))
                         + ((r0[0] * r0[0] + r0[1] * r0[1]) + (r0[2] * r0[2] + r0[3] * r0[3])) + ((r1[0] * r1[0] + r1[1] * r1[1]) + (r1[2] * r1[2] + r1[3] * r1[3]));
                ss += __shfl_xor(ss, 16); ss += __shfl_xor(ss, 32);
                const float rn = 1.0f / sqrtf(ss * (1.0f / 96.f) + EPS);
                r0 = r0 * rn * gr0; r1 = r1 * rn * gr1;
                const float* tp = T8 + (((fq < 2) ? (s >> 6) : (s & 63)) * 8 + ((4 * fq) & 7)) * 2;
                r0 = rope4t(r0, *(const f32x4*)tp); r1 = rope4t(r1, *(const f32x4*)(tp + 4));
                unsigned char* kp = (unsigned char*)Ka + ((size_t)(b * 8 + h) * SEQ + s) * 96 + 8 * fq;
                *(u32x2*)kp = pack8_fp8(a0 * rn * g00, a1 * rn * g01); *(u32x2*)(kp + 32) = pack8_fp8(c0 * rn * g10, c1 * rn * g11); *(u32x2*)(kp + 64) = pack8_fp8(r0, r1);
                asm volatile("" ::: "memory");
            EPI_ROWS_END
        }
    }
};
struct EpiMerge2 {
    static constexpr int MIDT = 4;
    const unsigned char* GATES; unsigned char* MG;
    __device__ __forceinline__ void mid(f32x4 (&acc)[2][2][4][2], const Unit& u, int wr, int wc, int fr, int fq) const {
        EPI_ROWS_BEGIN
#pragma unroll
            for (int bj = 0; bj < 2; ++bj) { const int c = u.pn * BM + EPI_COL(bj);
                f32x4 a0, a1, b0, b1; unpack8_fp8(*(const u32x2*)(GATES + (size_t)row * 2048 + c), a0, a1); unpack8_fp8(*(const u32x2*)(GATES + (size_t)row * 2048 + 1024 + c), b0, b1);
#pragma unroll
                for (int j = 0; j < 4; ++j) { acc[ai][bj][m][0][j] *= a0[j] * __builtin_amdgcn_rcpf(fmaxf(b0[j], 1e-30f)); acc[ai][bj][m][1][j] *= a1[j] * __builtin_amdgcn_rcpf(fmaxf(b1[j], 1e-30f)); } }
        EPI_ROWS_END4
    }
    __device__ __forceinline__ void operator()(const f32x4 (&acc)[2][2][4][2], const Unit& u, int wr, int wc, int fr, int fq) const {
        EPI_ROWS_BEGIN
#pragma unroll
            for (int bj = 0; bj < 2; ++bj) { const int c = u.pn * BM + EPI_COL(bj);
                f32x4 b0, b1; unpack8_fp8(*(const u32x2*)(GATES + (size_t)row * 2048 + 1024 + c), b0, b1);
                *(u32x2*)(MG + (size_t)row * DM + c) = pack8_fp8(acc[ai][bj][m][0] * b0 * 0.0001220703125f, acc[ai][bj][m][1] * b1 * 0.0001220703125f); }
        EPI_ROWS_END4
    }
};
struct EpiOut {
    static constexpr int MIDT = 0;
    const float* x; bf16_t* x1h; unsigned char* x1f8;
    __device__ __forceinline__ void operator()(const f32x4 (&acc)[2][2][4][2], const Unit& u, int wr, int wc, int fr, int fq) const {
        EPI_ROWS_BEGIN
#pragma unroll
            for (int bj = 0; bj < 2; ++bj) { const size_t o = (size_t)row * DM + u.pn * BM + EPI_COL(bj);
                const f32x4 v0 = acc[ai][bj][m][0] * 0.00048828125f + *(const f32x4*)(x + o), v1 = acc[ai][bj][m][1] * 0.00048828125f + *(const f32x4*)(x + o + 4);
                *(u32x4*)(x1h + o) = pack8_f16(v0, v1); *(u32x2*)(x1f8 + o) = pack8_fp8(v0, v1); }
        EPI_ROWS_END4
    }
};
struct EpiSwiGLU {
    static constexpr int MIDT = 0;
    const float* RG; unsigned char* ACT;
    __device__ __forceinline__ void operator()(const f32x4 (&acc)[2][2][4][2], const Unit& u, int wr, int wc, int fr, int fq) const {
        float rg_[2][4];
#pragma unroll
        for (int ai = 0; ai < 2; ++ai)
#pragma unroll
            for (int m = 0; m < 4; ++m) rg_[ai][m] = RG[u.pm * BM + ai * HALF + wr * 64 + m * 16 + fr];
        EPI_ROWS_BEGIN
            const float ri = rg_[ai][m] * 0.015625f;
            const float nl = ri * -1.4426950408889634f, r4 = 4.f * ri * ri;
            f32x4 a0, a1;
#pragma unroll
            for (int j = 0; j < 4; ++j) {
                a0[j] = (acc[ai][0][m][0][j] * acc[ai][1][m][0][j]) * r4 * __builtin_amdgcn_rcpf(1.f + __builtin_amdgcn_exp2f(acc[ai][0][m][0][j] * nl));
                a1[j] = (acc[ai][0][m][1][j] * acc[ai][1][m][1][j]) * r4 * __builtin_amdgcn_rcpf(1.f + __builtin_amdgcn_exp2f(acc[ai][0][m][1][j] * nl)); }
            *(u32x2*)(ACT + (size_t)row * FF + u.pn * HALF + wc * 32 + fq * 8) = pack8_fp8(a0, a1);
        EPI_ROWS_END
    }
};
struct EpiDown {
    static constexpr int MIDT = 0;
    const float* GATEV; unsigned char* YE;
    __device__ __forceinline__ void operator()(const f32x4 (&acc)[2][2][4][2], const Unit& u, int wr, int wc, int fr, int fq) const {
        float gv_[2][4];
#pragma unroll
        for (int ai = 0; ai < 2; ++ai)
#pragma unroll
            for (int m = 0; m < 4; ++m) gv_[ai][m] = GATEV[u.pm * BM + ai * HALF + wr * 64 + m * 16 + fr];
        EPI_ROWS_BEGIN
            const float gv = gv_[ai][m] * 0.25f;
#pragma unroll
            for (int bj = 0; bj < 2; ++bj) *(u32x2*)(YE + (size_t)row * DM + u.pn * BM + EPI_COL(bj)) = pack8_fp8(acc[ai][bj][m][0] * gv, acc[ai][bj][m][1] * gv);
        EPI_ROWS_END
    }
};
}

namespace att {
using bf16 = __hip_bfloat16;
constexpr int NW = 8, QBLK = 32, KVBLK = 64, DV = 64;
constexpr float THR = 8.f;
#define SBAR() __builtin_amdgcn_sched_barrier(0)
__device__ __forceinline__ int crow(int r, int hi) { return (r & 3) + 8 * (r >> 2) + 4 * hi; }
__device__ __forceinline__ unsigned cvtpk(float lo, float hi) { unsigned r; asm volatile("v_cvt_pk_bf16_f32 %0, %1, %2" : "=v"(r) : "v"(lo), "v"(hi)); return r; }

template <int DQK> struct Cfg4 {
    static constexpr int NK = (DQK + 63) / 64;
    static constexpr int KSTR = (DQK == 64) ? 80 : 144;
    static constexpr int VSTR = 144;
    static constexpr int KT = KVBLK * KSTR, VT = DV * VSTR;
    static constexpr int OFF_K = 0, OFF_V = 2 * KT, OFF_WS = OFF_V + 3 * VT, OFF_OST = OFF_WS + NW * 64 * 4, BYTES = OFF_OST + NW * 4096;
    static constexpr int NPK = KVBLK * DQK / 16;
};
typedef int v8i_t __attribute__((ext_vector_type(8)));
typedef int v4i_t __attribute__((ext_vector_type(4)));

template <int DQK>
__device__ __forceinline__ void load_q8(v8i_t (&qf)[Cfg4<DQK>::NK], const bf16_t* Qrow, const float* __restrict__ g, const float* __restrict__ TB, int spos, int hi) {
    constexpr int NK = Cfg4<DQK>::NK; constexpr float CS8 = ((DQK == 96) ? 0.14724444f : 0.18033688f) * 8.f;
    f32x4 v[NK][8]; float ss = 0.f;
#pragma unroll
    for (int j = 0; j < NK; ++j) { const bool valid = (DQK == 64) || (j == 0) || (hi == 0);
#pragma unroll
        for (int q = 0; q < 4; ++q) { u32x4 w = {0u, 0u, 0u, 0u}; if (valid) w = *reinterpret_cast<const u32x4*>(Qrow + 64 * j + 32 * hi + 8 * q); unpack8(w, v[j][2 * q], v[j][2 * q + 1]); }
#pragma unroll
        for (int q = 0; q < 8; ++q) ss += (v[j][q][0] * v[j][q][0] + v[j][q][1] * v[j][q][1]) + (v[j][q][2] * v[j][q][2] + v[j][q][3] * v[j][q][3]); }
    ss += __shfl_xor(ss, 32);
    const float rn = CS8 / sqrtf(ss * (1.0f / DQK) + EPS);
    const int prow = spos >> 6, pcol = spos & 63;
#pragma unroll
    for (int j = 0; j < NK; ++j) { const bool valid = (DQK == 64) || (j == 0) || (hi == 0); const int d0 = valid ? 64 * j + 32 * hi : 0;
#pragma unroll
        for (int q = 0; q < 8; ++q) { v[j][q] = v[j][q] * rn * *(const f32x4*)(g + d0 + 4 * q);
            if (DQK == 64) v[j][q] = rope4t(v[j][q], *(const f32x4*)(TB + ((hi ? pcol : prow) * 16 + 2 * q) * 2));
            else if (j == 1) v[j][q] = rope4t(v[j][q], *(const f32x4*)(TB + (((q < 4) ? prow : pcol) * 8 + 2 * (q & 3)) * 2)); }
        u32x2 w0 = pack8_fp8(v[j][0], v[j][1]), w1 = pack8_fp8(v[j][2], v[j][3]), w2 = pack8_fp8(v[j][4], v[j][5]), w3 = pack8_fp8(v[j][6], v[j][7]);
        if (!valid) { w0 = (u32x2){0u, 0u}; w1 = w0; w2 = w0; w3 = w0; }
        qf[j] = (v8i_t){(int)w0.x, (int)w0.y, (int)w1.x, (int)w1.y, (int)w2.x, (int)w2.y, (int)w3.x, (int)w3.y}; }
}

template <int DQK, bool SHIFT>
__device__ __forceinline__ void attn_step4(f32x16& C0, f32x16& C1, f32x16& N0, f32x16& N1, bf16x8& W0, bf16x8& W1, bf16x8& W2, bf16x8& W3,
                                           const bf16x8& R0, const bf16x8& R1, const bf16x8& R2, const bf16x8& R3, f32x16 (&o)[2], float& l0, float& l1, float& l2, float& l3,
                                           const v8i_t (&qf)[Cfg4<DQK>::NK], const LAS char* kp, const LAS char* vp, int sc_k, int sc_q, float nsh) {
    constexpr int KSTR = Cfg4<DQK>::KSTR, NK = Cfg4<DQK>::NK, NQ = 2 * NK, NS = NQ + 8;
    v8i_t kq[NQ]; bf16x8 vfr_[8];
#define SLOT_ISQ(s) ((DQK == 64) ? ((s) == 0 || (s) == 5) : (((s) % 3) == 0))
#define SLOT_IDX(s) ((DQK == 64) ? (SLOT_ISQ(s) ? ((s) == 5) : ((s) < 5 ? (s) - 1 : (s) - 2)) : (SLOT_ISQ(s) ? (s) / 3 : (s) - (s) / 3 - 1))
#define FRAG_RD(s) do { if ((s) < NS) { if (SLOT_ISQ(s)) { const int i_ = SLOT_IDX(s); const LAS char* p_ = kp + (i_ & 1) * 32 * KSTR + (i_ >> 1) * 64; \
            kq[i_] = __builtin_shufflevector(*(const LAS v4i_t*)p_, *(const LAS v4i_t*)(p_ + 16), 0, 1, 2, 3, 4, 5, 6, 7); } \
        else { const int j_ = SLOT_IDX(s); vfr_[j_] = *(const LAS bf16x8*)(vp + (j_ & 1) * 32 * Cfg4<DQK>::VSTR + (j_ >> 1) * 32); } } } while (0)
#define EXPQ(P, B) do { if (SHIFT) { P[B] += nsh; P[B + 1] += nsh; P[B + 2] += nsh; P[B + 3] += nsh; } \
        P[B] = __builtin_amdgcn_exp2f(P[B]); P[B + 1] = __builtin_amdgcn_exp2f(P[B + 1]); P[B + 2] = __builtin_amdgcn_exp2f(P[B + 2]); P[B + 3] = __builtin_amdgcn_exp2f(P[B + 3]); } while (0)
#define ADDQ(P, B) do { l0 += P[B]; l1 += P[B + 1]; l2 += P[B + 2]; l3 += P[B + 3]; } while (0)
#define PKN(P, BASE, OUT) do { u32x4 w_ = {cvtpk(P[BASE + 0], P[BASE + 1]), cvtpk(P[BASE + 2], P[BASE + 3]), cvtpk(P[BASE + 4], P[BASE + 5]), cvtpk(P[BASE + 6], P[BASE + 7])}; OUT = __builtin_bit_cast(bf16x8, w_); } while (0)
#define CHUNK(g) do { \
        if ((g) == 0) { EXPQ(C0, 4); ADDQ(C0, 0); } else if ((g) == 1) { EXPQ(C0, 8); ADDQ(C0, 4); } else if ((g) == 2) { PKN(C0, 0, W0); EXPQ(C0, 12); } \
        else if ((g) == 3) { ADDQ(C0, 8); EXPQ(C1, 0); } else if ((g) == 4) { ADDQ(C0, 12); PKN(C0, 8, W1); } else if ((g) == 5) { EXPQ(C1, 4); ADDQ(C1, 0); } \
        else if ((g) == 6) { EXPQ(C1, 8); ADDQ(C1, 4); } else if ((g) == 7) { PKN(C1, 0, W2); EXPQ(C1, 12); } else if ((g) == 8) { ADDQ(C1, 8); ADDQ(C1, 12); } \
        else if ((g) == 9) { PKN(C1, 8, W3); } } while (0)
    FRAG_RD(0); FRAG_RD(1);
    EXPQ(C0, 0);
    __builtin_amdgcn_sched_barrier(0);
#pragma unroll
    for (int s = 0; s < NS; ++s) {
        if (SLOT_ISQ(s)) { const int i = SLOT_IDX(s);
            if ((i >> 1) == 0) { if (i & 1) asm volatile("v_mfma_scale_f32_32x32x64_f8f6f4 %0, %1, %2, 0, %3, %4 op_sel_hi:[0,0,0]" : "=&v"(N1) : "v"(kq[i]), "v"(qf[0]), "v"(sc_k), "v"(sc_q));
                                 else       asm volatile("v_mfma_scale_f32_32x32x64_f8f6f4 %0, %1, %2, 0, %3, %4 op_sel_hi:[0,0,0]" : "=&v"(N0) : "v"(kq[i]), "v"(qf[0]), "v"(sc_k), "v"(sc_q)); }
            else               { if (i & 1) asm volatile("v_mfma_scale_f32_32x32x64_f8f6f4 %0, %1, %2, %0, %3, %4 op_sel_hi:[0,0,0]" : "+v"(N1) : "v"(kq[i]), "v"(qf[NK - 1]), "v"(sc_k), "v"(sc_q));
                                 else       asm volatile("v_mfma_scale_f32_32x32x64_f8f6f4 %0, %1, %2, %0, %3, %4 op_sel_hi:[0,0,0]" : "+v"(N0) : "v"(kq[i]), "v"(qf[NK - 1]), "v"(sc_k), "v"(sc_q)); }
        } else { const int j = SLOT_IDX(s);
            const bf16x8 pa = ((j >> 1) == 0) ? R0 : ((j >> 1) == 1) ? R1 : ((j >> 1) == 2) ? R2 : R3;
            o[j & 1] = __builtin_amdgcn_mfma_f32_32x32x16_bf16(pa, vfr_[j], o[j & 1], 0, 0, 0); }
        FRAG_RD(s + 2);
        CHUNK(s);
        __builtin_amdgcn_sched_barrier(0);
    }
#undef SLOT_ISQ
#undef SLOT_IDX
#undef FRAG_RD
#undef EXPQ
#undef ADDQ
#undef PKN
#undef CHUNK
}

template <int DQK, int LDO, bool SHIFT>
__device__ __forceinline__ void attn_unit4(const bf16_t* __restrict__ Qb, const unsigned char* __restrict__ Kh, const bf16_t* __restrict__ Vh, unsigned char* __restrict__ Ob, int seq, LAS char* lds, float negMref, const float* gq, const float* TB, int q0) {
    using C = Cfg4<DQK>; constexpr int NK = C::NK;
    int tid = threadIdx.x; asm volatile("" : "+v"(tid));
    const int wid = tid >> 6, lane = tid & 63, r32 = lane & 31, hi = lane >> 5;
    LAS char* K_lds = lds + C::OFF_K; LAS char* V_lds = lds + C::OFF_V;
    f32x16 o[2] = {}; v8i_t qf[NK]; float l0 = 0.f, l1 = 0.f, l2 = 0.f, l3 = 0.f;
    const int sc_k = 0x7f7f7f7f, sc_q = 0x7c7c7c7c;
    constexpr int CPR = DQK / 16;
    const bool kact = tid < C::NPK; const int kr = tid / CPR, kc = tid - kr * CPR, kst0 = kr * C::KSTR + kc * 16;
    const int sr = tid >> 3, sc = (tid & 7) * 8, vst0 = sr * C::VSTR + sc * 2;
    if (DQK == 96) {
        if (tid < 256) { const int slot = tid >> 7, r_ = (tid >> 1) & 63, c_ = tid & 1; *(LAS u32x4*)(K_lds + slot * C::KT + r_ * C::KSTR + 96 + 16 * c_) = (u32x4){0u, 0u, 0u, 0u}; } }
    const LAS char* kfr = K_lds + r32 * C::KSTR + hi * 32;
    const LAS char* vfr = V_lds + r32 * C::VSTR + hi * 16;
    u32x4 ks0 = {0u, 0u, 0u, 0u}; bf16x8 vs;
#define LOADK(t) do { if (kact) ks0 = *reinterpret_cast<const u32x4*>(Kh + (long)(t) * KVBLK * DQK + tid * 16); } while (0)
#define LOADV(t) do { vs = *reinterpret_cast<const bf16x8*>(&Vh[(long)sr * seq + (t) * KVBLK + sc]); } while (0)
#define WRITEK(slotoff) do { if (kact) *(LAS u32x4*)(K_lds + (slotoff) + kst0) = ks0; } while (0)
#define WRITEV(slotoff) do { *(LAS bf16x8*)(V_lds + (slotoff) + vst0) = vs; } while (0)
    const int NT = seq / KVBLK;
    {
        u32x4 kp1 = {0u, 0u, 0u, 0u};
        LOADK(0); if (kact) kp1 = *reinterpret_cast<const u32x4*>(Kh + (long)KVBLK * DQK + tid * 16); LOADV(0);
        load_q8<DQK>(qf, Qb + (long)(wid * QBLK + r32) * DQK, gq, TB, q0 + wid * QBLK + r32, hi);
        WRITEK(0); WRITEV(0); if (kact) *(LAS u32x4*)(K_lds + C::KT + kst0) = kp1;
        LOADK(2); LOADV(1);
    }
    __syncthreads();
    f32x16 pA0, pA1, pB0, pB1; bf16x8 xa0 = {}, xa1 = {}, xa2 = {}, xa3 = {}, ya0 = {}, ya1 = {}, ya2 = {}, ya3 = {};
    {
#pragma unroll
        for (int j = 0; j < NK; ++j) {
            const LAS char* p0_ = kfr + j * 64; const LAS char* p1_ = p0_ + 32 * C::KSTR;
            const v8i_t k0_ = __builtin_shufflevector(*(const LAS v4i_t*)p0_, *(const LAS v4i_t*)(p0_ + 16), 0, 1, 2, 3, 4, 5, 6, 7);
            const v8i_t k1_ = __builtin_shufflevector(*(const LAS v4i_t*)p1_, *(const LAS v4i_t*)(p1_ + 16), 0, 1, 2, 3, 4, 5, 6, 7);
            if (j == 0) { asm volatile("v_mfma_scale_f32_32x32x64_f8f6f4 %0, %1, %2, 0, %3, %4 op_sel_hi:[0,0,0]" : "=&v"(pA0) : "v"(k0_), "v"(qf[0]), "v"(sc_k), "v"(sc_q));
                          asm volatile("v_mfma_scale_f32_32x32x64_f8f6f4 %0, %1, %2, 0, %3, %4 op_sel_hi:[0,0,0]" : "=&v"(pA1) : "v"(k1_), "v"(qf[0]), "v"(sc_k), "v"(sc_q)); }
            else        { asm volatile("v_mfma_scale_f32_32x32x64_f8f6f4 %0, %1, %2, %0, %3, %4 op_sel_hi:[0,0,0]" : "+v"(pA0) : "v"(k0_), "v"(qf[NK - 1]), "v"(sc_k), "v"(sc_q));
                          asm volatile("v_mfma_scale_f32_32x32x64_f8f6f4 %0, %1, %2, %0, %3, %4 op_sel_hi:[0,0,0]" : "+v"(pA1) : "v"(k1_), "v"(qf[NK - 1]), "v"(sc_k), "v"(sc_q)); } }
        asm volatile("s_nop 15\n\ts_nop 15" ::: "memory");
    }
#define VFRAG(L, H) (bf16x8){L[0], L[1], L[2], L[3], H[0], H[1], H[2], H[3]}
#define STEP(C0, C1, N0, N1, W0, W1, W2, W3, R0, R1, R2, R3, koff, voff) attn_step4<DQK, SHIFT>(C0, C1, N0, N1, W0, W1, W2, W3, R0, R1, R2, R3, o, l0, l1, l2, l3, qf, kfr + (koff), vfr + (voff), sc_k, sc_q, negMref)
    int kcur = C::KT, vprev = 0, vnext = C::VT;
    for (int t = 0; t < NT; t += 2) {
        __syncthreads();
        WRITEK(C::KT - kcur); WRITEV(vnext);
        { const int tk = (t + 3 < NT) ? t + 3 : NT - 1, tv = (t + 2 < NT) ? t + 2 : NT - 1; LOADK(tk); LOADV(tv); }
        STEP(pA0, pA1, pB0, pB1, xa0, xa1, xa2, xa3, ya0, ya1, ya2, ya3, kcur, vprev);
        vprev = (t == 0) ? 0 : (vprev == 2 * C::VT ? 0 : vprev + C::VT); vnext = (vnext == 2 * C::VT) ? 0 : vnext + C::VT; kcur = C::KT - kcur;
        __syncthreads();
        WRITEK(C::KT - kcur); WRITEV(vnext);
        { const int tk = (t + 4 < NT) ? t + 4 : NT - 1, tv = (t + 3 < NT) ? t + 3 : NT - 1; LOADK(tk); LOADV(tv); }
        STEP(pB0, pB1, pA0, pA1, ya0, ya1, ya2, ya3, xa0, xa1, xa2, xa3, kcur, vprev);
        vprev = (vprev == 2 * C::VT) ? 0 : vprev + C::VT; vnext = (vnext == 2 * C::VT) ? 0 : vnext + C::VT; kcur = C::KT - kcur;
    }
    {   const LAS char* vp_ = vfr + vprev;
#pragma unroll
        for (int d0 = 0; d0 < 2; ++d0) {
            const bf16x8 f0 = *(const LAS bf16x8*)(vp_ + d0 * 32 * C::VSTR), f1 = *(const LAS bf16x8*)(vp_ + d0 * 32 * C::VSTR + 32), f2 = *(const LAS bf16x8*)(vp_ + d0 * 32 * C::VSTR + 64), f3 = *(const LAS bf16x8*)(vp_ + d0 * 32 * C::VSTR + 96);
            o[d0] = __builtin_amdgcn_mfma_f32_32x32x16_bf16(ya0, f0, o[d0], 0, 0, 0); o[d0] = __builtin_amdgcn_mfma_f32_32x32x16_bf16(ya1, f1, o[d0], 0, 0, 0);
            o[d0] = __builtin_amdgcn_mfma_f32_32x32x16_bf16(ya2, f2, o[d0], 0, 0, 0); o[d0] = __builtin_amdgcn_mfma_f32_32x32x16_bf16(ya3, f3, o[d0], 0, 0, 0); }
    }
    float l_reg = (l0 + l1) + (l2 + l3);
    { auto rr = __builtin_amdgcn_permlane32_swap(__float_as_uint(l_reg), __float_as_uint(l_reg), false, false); l_reg = __uint_as_float(rr[0]) + __uint_as_float(rr[1]); }
    LAS float* ws = (LAS float*)(lds + C::OFF_WS) + wid * 64;
    if (hi == 0) ws[r32] = l_reg;
    asm volatile("s_waitcnt lgkmcnt(0)" ::: "memory");
    float rli[16];
#pragma unroll
    for (int r = 0; r < 16; ++r) rli[r] = __builtin_amdgcn_rcpf(ws[crow(r, hi)]);
    unsigned char* Ow = Ob + (long)(wid * QBLK) * LDO;
    { LAS unsigned char* stg = (LAS unsigned char*)(lds + C::OFF_OST) + wid * 2048;
#pragma unroll
      for (int r = 0; r < 16; ++r) { const int orow = crow(r, hi); const float sc_ = rli[r] * 64.f;
          const int w_ = __builtin_amdgcn_cvt_pk_fp8_f32(o[0][r] * sc_, o[1][r] * sc_, 0, false);
          stg[orow * 64 + r32] = (unsigned char)(w_ & 0xff); stg[orow * 64 + 32 + r32] = (unsigned char)((w_ >> 8) & 0xff); }
      asm volatile("s_waitcnt lgkmcnt(0)" ::: "memory");
#pragma unroll
      for (int i = 0; i < 2; ++i) { const int row = i * 16 + (lane >> 2), ch = lane & 3; const u32x4 v = *(const LAS u32x4*)(stg + row * 64 + ch * 16); *(u32x4*)(Ow + (long)row * LDO + ch * 16) = v; } }
    asm volatile("s_waitcnt lgkmcnt(0)" ::: "memory"); __syncthreads();
#undef LOADK
#undef LOADV
#undef WRITEK
#undef WRITEV
#undef VFRAG
#undef STEP
}
#undef SBAR
}

constexpr size_t MiB = 1u << 20;
constexpr size_t WS_CTL = 0, CTL_ZERO_BYTES = 64 * 1024;
constexpr size_t WS_RINV1 = 1 * MiB, WS_RINV2 = 1 * MiB + 512 * 1024, WS_SSQ = 2 * MiB, WS_AFF = 4 * MiB, WS_IDX = 6 * MiB, WS_GATEV = 6 * MiB + 256 * 1024, WS_RG = 6 * MiB + 512 * 1024, WS_INV = 7 * MiB;
constexpr size_t WS_ROPE16 = 6 * MiB + 768 * 1024, WS_ROPE8 = WS_ROPE16 + 8192;
constexpr size_t WS_WIN = 9 * MiB, WS_WQUP = 17 * MiB, WS_WKVUP = 18 * MiB + 256 * 1024, WS_WA = 19 * MiB, WS_WB = 20 * MiB, WS_WO = 21 * MiB;
constexpr size_t WS_XB = 24 * MiB;
constexpr size_t WS_MG = 56 * MiB;
constexpr size_t WS_LAT = 88 * MiB;
constexpr size_t WS_GATES = 154 * MiB;
constexpr size_t WS_X1H = WS_GATES;
constexpr size_t WS_QB = 218 * MiB, WS_KB = 250 * MiB, WS_VB = 254 * MiB, WS_QA = 262 * MiB, WS_KA = 310 * MiB, WS_VA = 334 * MiB;
constexpr size_t WS_WGU = 366 * MiB, WS_WD = 398 * MiB;
constexpr size_t WS_ACT = 88 * MiB, WS_XE = 218 * MiB;
constexpr size_t WS_END = 414 * MiB;


#define XB_TMO      128
#define XB_XCNT(j)  (256  + 64 * (j))
#define XB_XSUB(j)  (1280 + 64 * (j))
#define XB_XGEN(j)  (2304 + 64 * (j))
#define XB_TOP      3328
#define XB_TOPGEN   3392
#define XCD_BAR_WORDS 3456
#define XB_SPIN_CAP (1u << 22)
__device__ __forceinline__ unsigned xb_ld(unsigned* p)              { return __hip_atomic_load(p, __ATOMIC_RELAXED, __HIP_MEMORY_SCOPE_AGENT); }
__device__ __forceinline__ unsigned xb_add(unsigned* p, unsigned v) { return __hip_atomic_fetch_add(p, v, __ATOMIC_RELAXED, __HIP_MEMORY_SCOPE_AGENT); }
__device__ __forceinline__ unsigned xb_xcc_id() { return (unsigned)__builtin_amdgcn_s_getreg((3 << 11) | 20) & 0xFu; }
#define XB_SPIN(cond, bar) do { unsigned _sp = 0; while (cond) { __builtin_amdgcn_s_sleep(1); \
    if ((++_sp & 255u) == 0u) { if (xb_ld(&(bar)[XB_TMO])) break; if (_sp > XB_SPIN_CAP) { atomicAdd(&(bar)[XB_TMO], 1u); break; } } } } while (0)
struct XcdBarrier { unsigned* bar; unsigned x; volatile LAS unsigned* st; };
__device__ __forceinline__ XcdBarrier xcd_barrier_post(unsigned* bar, volatile LAS unsigned* st) {
    XcdBarrier b; b.bar = bar; b.x = xb_xcc_id(); b.st = st;
    if (threadIdx.x == 0) st[2] = xb_add(&bar[XB_XCNT(b.x)], 1u);
    return b;
}
__device__ __forceinline__ void xcd_barrier_complete(unsigned* bar, unsigned x, unsigned& nloc, unsigned& nx, unsigned& uni) {
    const unsigned G = gridDim.x * gridDim.y * gridDim.z;
    unsigned sum, cnt, mine, sp = 0u, u32c;
    for (;;) {
        sum = 0u; cnt = 0u; mine = 0u; u32c = 0u;
#pragma unroll
        for (unsigned j = 0; j < 16; ++j) { const unsigned c = xb_ld(&bar[XB_XCNT(j)]); sum += c; cnt += (c > 0u) ? 1u : 0u; mine = (j == x) ? c : mine; u32c += (j < 8u && c == 32u) ? 1u : 0u; }
        if (sum == G) break;
        __builtin_amdgcn_s_sleep(1);
        if ((++sp & 255u) == 0u) { if (xb_ld(&bar[XB_TMO])) break; if (sp > XB_SPIN_CAP) { atomicAdd(&bar[XB_TMO], 1u); break; } }
    }
    nloc = mine > 0u ? mine : 1u; nx = cnt > 0u ? cnt : 1u;
    uni = (sum == G && G == 256u && cnt == 8u && u32c == 8u) ? 1u : 0u;
}
__device__ __forceinline__ void xcd_barrier(const XcdBarrier& b) {
    asm volatile("s_waitcnt vmcnt(0)" ::: "memory");
    __syncthreads();
    if (threadIdx.x == 0) {
        unsigned* bar = b.bar;
        __builtin_amdgcn_s_waitcnt(0);
        unsigned nloc = b.st[0], nx = b.st[1];
        if (nloc == 0u) { unsigned uni; xcd_barrier_complete(bar, b.x, nloc, nx, uni); b.st[0] = nloc; b.st[1] = nx; b.st[3] = uni; }
        const unsigned old = xb_add(&bar[XB_XSUB(b.x)], 1u);
        const unsigned gen = old / nloc;
        if (old + 1u == (gen + 1u) * nloc) {
            __builtin_amdgcn_fence(__ATOMIC_RELEASE, "agent");
            asm volatile("s_waitcnt vmcnt(0)" ::: "memory");
            const unsigned og = xb_add(&bar[XB_TOP], 1u);
            const unsigned tg = og / nx;
            if (og + 1u == (tg + 1u) * nx) xb_add(&bar[XB_TOPGEN], 1u);
            else XB_SPIN(xb_ld(&bar[XB_TOPGEN]) == tg, bar);
            __builtin_amdgcn_fence(__ATOMIC_ACQUIRE, "agent");
            xb_add(&bar[XB_XGEN(b.x)], 1u);
            asm volatile("s_waitcnt vmcnt(0)" ::: "memory");
        } else {
            XB_SPIN(xb_ld(&bar[XB_XGEN(b.x)]) == gen, bar);
            __builtin_amdgcn_fence(__ATOMIC_ACQUIRE, "agent");
            asm volatile("s_waitcnt vmcnt(0)" ::: "memory");
        }
    }
    __syncthreads();
}

__device__ __forceinline__ void xcd_barrier_local(const XcdBarrier& b) {
    asm volatile("s_waitcnt vmcnt(0)" ::: "memory");
    __syncthreads();
    if (threadIdx.x == 0) {
        unsigned* bar = b.bar;
        __builtin_amdgcn_s_waitcnt(0);
        const unsigned nloc = b.st[0];
        const unsigned old = xb_add(&bar[XB_XSUB(b.x)], 1u);
        const unsigned gen = old / nloc;
        if (old + 1u == (gen + 1u) * nloc) xb_add(&bar[XB_XGEN(b.x)], 1u);
        else XB_SPIN(xb_ld(&bar[XB_XGEN(b.x)]) == gen, bar);
        __builtin_amdgcn_fence(__ATOMIC_ACQUIRE, "agent");
        asm volatile("s_waitcnt vmcnt(0)" ::: "memory");
    }
    __syncthreads();
}

constexpr int LDS_BYTES = 147456;
struct Args {
    const float* in[21]; float* out; unsigned char* ws; int ph_lo, ph_hi;
};
__device__ __forceinline__ float wave_sum(float v) {
#pragma unroll
    for (int o = 1; o < 64; o <<= 1) v += __shfl_xor(v, o);
    return v;
}
__device__ __forceinline__ void tr_item(const float* W, int K, int N, int k0, int n0, bf16_t* WT, int prow0, const float* g, LAS float* scr, int lane) {
#pragma unroll 8
    for (int i = 0; i < 32; ++i) { const int kk = 2 * i + (lane >> 5); float w = W[(size_t)(k0 + kk) * N + n0 + (lane & 31)]; if (g) w *= g[k0 + kk]; scr[kk * 33 + (lane & 31)] = w; }
    asm volatile("s_waitcnt lgkmcnt(0)" ::: "memory");
    const int c = lane & 7;
#pragma unroll
    for (int j = 0; j < 4; ++j) { const int n = (lane >> 3) + 8 * j; const LAS float* s = scr + (8 * c) * 33 + n;
        u32x4 o; o.x = cvt_pk_bf16(s[0 * 33], s[1 * 33]); o.y = cvt_pk_bf16(s[2 * 33], s[3 * 33]); o.z = cvt_pk_bf16(s[4 * 33], s[5 * 33]); o.w = cvt_pk_bf16(s[6 * 33], s[7 * 33]);
        *(u32x4*)(WT + (size_t)(prow0 + n) * K + k0 + 8 * c) = o; }
    asm volatile("s_waitcnt lgkmcnt(0)" ::: "memory");
}
__device__ __forceinline__ void tr_item64(const float* W, int K, int N, int k0, int n0, bf16_t* WT, int prow0, int prow1, const float* g, LAS float* scr, int lane) {
    f32x4 v[16]; const int kr = lane >> 4, n4 = (lane & 15) * 4;
#pragma unroll
    for (int i = 0; i < 16; ++i) v[i] = *(const f32x4*)(W + (size_t)(k0 + 4 * i + kr) * N + n0 + n4);
#pragma unroll
    for (int i = 0; i < 16; ++i) { const int k = 4 * i + kr; const float gs = g ? g[k0 + k] : 1.f; LAS float* d = scr + k * 65 + n4;
        d[0] = v[i][0] * gs; d[1] = v[i][1] * gs; d[2] = v[i][2] * gs; d[3] = v[i][3] * gs; }
    asm volatile("s_waitcnt lgkmcnt(0)" ::: "memory");
    const int c = lane >> 3;
#pragma unroll
    for (int j = 0; j < 8; ++j) { const int n = (lane & 7) + 8 * j; const LAS float* s = scr + (8 * c) * 65 + n;
        u32x4 o; o.x = cvt_pk_bf16(s[0 * 65], s[1 * 65]); o.y = cvt_pk_bf16(s[2 * 65], s[3 * 65]); o.z = cvt_pk_bf16(s[4 * 65], s[5 * 65]); o.w = cvt_pk_bf16(s[6 * 65], s[7 * 65]);
        *(u32x4*)(WT + (size_t)((j < 4) ? prow0 + n : prow1 + n - 32) * K + k0 + 8 * c) = o; }
    asm volatile("s_waitcnt lgkmcnt(0)" ::: "memory");
}
__device__ __forceinline__ void tr_item64_f8(const float* W, int K, int N, int k0, int n0, unsigned char* WT, int prow0, int prow1, const float* g, float sc, LAS float* scr, int lane) {
    f32x4 v[16]; const int kr = lane >> 4, n4 = (lane & 15) * 4;
#pragma unroll
    for (int i = 0; i < 16; ++i) v[i] = *(const f32x4*)(W + (size_t)(k0 + 4 * i + kr) * N + n0 + n4);
#pragma unroll
    for (int i = 0; i < 16; ++i) { const int k = 4 * i + kr; const float gs = (g ? g[k0 + k] : 1.f) * sc; LAS float* d = scr + k * 65 + n4;
        d[0] = v[i][0] * gs; d[1] = v[i][1] * gs; d[2] = v[i][2] * gs; d[3] = v[i][3] * gs; }
    asm volatile("s_waitcnt lgkmcnt(0)" ::: "memory");
    const int kc = lane >> 4;
#pragma unroll
    for (int j = 0; j < 4; ++j) { const int n = (lane & 15) + 16 * j; const LAS float* sp = scr + (16 * kc) * 65 + n;
        u32x4 o; unsigned w_[4];
#pragma unroll
        for (int q = 0; q < 4; ++q) { int t = __builtin_amdgcn_cvt_pk_fp8_f32(sp[(4 * q) * 65], sp[(4 * q + 1) * 65], 0, false); t = __builtin_amdgcn_cvt_pk_fp8_f32(sp[(4 * q + 2) * 65], sp[(4 * q + 3) * 65], t, true); w_[q] = (unsigned)t; }
        o.x = w_[0]; o.y = w_[1]; o.z = w_[2]; o.w = w_[3];
        *(u32x4*)(WT + (size_t)((j < 2) ? prow0 + n : prow1 + n - 32) * K + k0 + 16 * kc) = o; }
    asm volatile("s_waitcnt lgkmcnt(0)" ::: "memory");
}
__device__ __forceinline__ void tr_item_f8(const float* W, int K, int N, int k0, int n0, unsigned char* WT, int prow0, const float* g, float sc, LAS float* scr, int lane) {
#pragma unroll 8
    for (int i = 0; i < 32; ++i) { const int kk = 2 * i + (lane >> 5); float w = W[(size_t)(k0 + kk) * N + n0 + (lane & 31)] * sc; if (g) w *= g[k0 + kk]; scr[kk * 33 + (lane & 31)] = w; }
    asm volatile("s_waitcnt lgkmcnt(0)" ::: "memory");
    const int n = lane & 31;
#pragma unroll
    for (int j = 0; j < 2; ++j) { const int kc = (lane >> 5) + 2 * j; const LAS float* sp = scr + (16 * kc) * 33 + n; unsigned w_[4];
#pragma unroll
        for (int q = 0; q < 4; ++q) { int t = __builtin_amdgcn_cvt_pk_fp8_f32(sp[(4 * q) * 33], sp[(4 * q + 1) * 33], 0, false); t = __builtin_amdgcn_cvt_pk_fp8_f32(sp[(4 * q + 2) * 33], sp[(4 * q + 3) * 33], t, true); w_[q] = (unsigned)t; }
        u32x4 o; o.x = w_[0]; o.y = w_[1]; o.z = w_[2]; o.w = w_[3];
        *(u32x4*)(WT + (size_t)(prow0 + n) * K + k0 + 16 * kc) = o; }
    asm volatile("s_waitcnt lgkmcnt(0)" ::: "memory");
}
__device__ __forceinline__ int win_prow(int n) {
    if (n < 1056) return n;
    if (n < 1568) return 1280 + (n - 1056);
    if (n < 1696) { const int j = n - 1568; return 1792 + ((j >> 5) & 1) * 128 + 32 * (j >> 6); }
    if (n < 1824) { const int j = n - 1696; return 1792 + ((j >> 5) & 1) * 128 + 32 * (2 + (j >> 6)); }
    return 2048 + (n - 1824);
}
__device__ __forceinline__ int block_scan(int v, int& tot, LAS int* scr, int tid) {
    const int lane = tid & 63, w = tid >> 6; int x = v;
#pragma unroll
    for (int o = 1; o < 64; o <<= 1) { const int y = __shfl_up(x, o); if (lane >= o) x += y; }
    __syncthreads();
    if (lane == 63) scr[w] = x;
    __syncthreads();
    int base = 0, t = 0;
#pragma unroll
    for (int i = 0; i < 8; ++i) { const int s = scr[i]; if (i < w) base += s; t += s; }
    tot = t; return base + x - v;
}

__global__ void __launch_bounds__(512, 2) fwd_kernel(const Args args) {
    extern __shared__ __attribute__((aligned(16))) unsigned char lds[];
    LAS unsigned char* ldsl = (LAS unsigned char*)lds;
    __builtin_assume(__builtin_amdgcn_workitem_id_y() == 0); __builtin_assume(__builtin_amdgcn_workitem_id_z() == 0);
    const int wave = __builtin_amdgcn_readfirstlane(threadIdx.x >> 6);
    const int G = gridDim.x; int bx = blockIdx.x;
#define PHASE_TID() int tid = threadIdx.x; asm volatile("" : "+v"(tid)); const int lane = tid & 63; (void)lane
    int vcu = (G % 8 == 0) ? (bx % 8) * (G / 8) + bx / 8 : bx;
    int gw = vcu * 8 + wave; const int NGW = G * 8;
    bool xloc = false;
#define AS4 __attribute__((address_space(4)))
#define PHASE_ARGS() const Args AS4* KA_ = (const Args AS4*)__builtin_amdgcn_kernarg_segment_ptr(); asm volatile("" : "+s"(KA_)); unsigned char* const ws = KA_->ws; (void)ws
#define INP(i) (KA_->in[i])
#define WSP(TY, off) ((TY*)(ws + (off)))
    const int lo = args.ph_lo, hi = args.ph_hi;
#define IN(k) (lo <= (k) && (k) < hi)
#if MK_CG
#define SEAM(k) do { if (IN(k) && IN((k) + 1)) { cg::this_grid().sync(); } } while (0)
#define SEAM_L(k) SEAM(k)
#else
    volatile LAS unsigned* bst = (volatile LAS unsigned*)(ldsl + LDS_BYTES - 64);
    if (threadIdx.x < 4) bst[threadIdx.x] = 0u;
    __syncthreads();
    XcdBarrier xbar;
    { unsigned* barw = (unsigned*)(args.ws + WS_CTL) + 4096; xbar = xcd_barrier_post(barw, bst); }
#define SEAM(k) do { if (IN(k) && IN((k) + 1)) { xcd_barrier(xbar); } } while (0)
#define SEAM_L(k) do { if (IN(k) && IN((k) + 1)) { if (xloc) xcd_barrier_local(xbar); else xcd_barrier(xbar); } } while (0)
#endif

    if (IN(0)) REPS(0) {
        PHASE_TID(); PHASE_ARGS();
        const float* x = INP(0); const float* g_attn = INP(1); const float* w_in = INP(2); const float* g_q_lat = INP(4); const float* w_q_up = INP(5); const float* g_kv_lat = INP(6); const float* w_kv_up = INP(7);
        const float* w_mla_br = INP(12); const float* w_gqa_br = INP(13); const float* w_out = INP(14);
        bf16_t* Win_t = WSP(bf16_t, WS_WIN); bf16_t* Wqup_t = WSP(bf16_t, WS_WQUP); bf16_t* Wkvup_t = WSP(bf16_t, WS_WKVUP); bf16_t* Wa_t = WSP(bf16_t, WS_WA); bf16_t* Wb_t = WSP(bf16_t, WS_WB); bf16_t* Wo_t = WSP(bf16_t, WS_WO);
        bf16_t* XB = WSP(bf16_t, WS_XB); float* RINV1 = WSP(float, WS_RINV1);
        LAS float* scr = (LAS float*)(ldsl + wave * 16640);
        constexpr int I_IN = 16 * 61, I_QUP = 12 * 12, I_KVUP = 4 * 16, I_BR = 8 * 16, I_O = 16 * 16;
        constexpr int NITEMS = I_IN + I_QUP + I_KVUP + 2 * I_BR + I_O;
        for (int it = gw; it < NITEMS; it += NGW) {
            int r = it;
            if (r < I_IN) { const int kb = r / 61, nb = r % 61;
                if (nb < 60) tr_item64_f8(w_in, 1024, 3872, kb * 64, nb * 64, (unsigned char*)Win_t, win_prow(nb * 64), win_prow(nb * 64 + 32), g_attn, 32.f, scr, lane);
                else tr_item_f8(w_in, 1024, 3872, kb * 64, 3840, (unsigned char*)Win_t, win_prow(3840), g_attn, 32.f, scr, lane);
                continue; } r -= I_IN;
            if (r < I_QUP) { const int kb = r / 12, nb = r % 12; tr_item64(w_q_up, 768, 768, kb * 64, nb * 64, Wqup_t, nb * 64, nb * 64 + 32, g_q_lat, scr, lane); continue; } r -= I_QUP;
            if (r < I_KVUP) { const int kb = r / 16, nb = r % 16, n2 = 2 * nb;
                const int p0 = ((n2 >> 3) * 256) + 32 * (2 * ((n2 >> 2) & 1) + ((n2 >> 1) & 1)); tr_item64(w_kv_up, 256, 1024, kb * 64, nb * 64, Wkvup_t, p0, p0 + 128, g_kv_lat, scr, lane); continue; } r -= I_KVUP;
            if (r < I_BR) { const int kb = r / 16, nb = r % 16; tr_item64_f8(w_mla_br, 1024, 1024, kb * 64, nb * 64, (unsigned char*)Wa_t, nb * 64, nb * 64 + 32, nullptr, 32.f, scr, lane); continue; } r -= I_BR;
            if (r < I_BR) { const int kb = r / 16, nb = r % 16; tr_item64_f8(w_gqa_br, 1024, 1024, kb * 64, nb * 64, (unsigned char*)Wa_t + 512, nb * 64, nb * 64 + 32, nullptr, 32.f, scr, lane); continue; } r -= I_BR;
            { const int kb = r / 16, nb = r % 16; tr_item64_f8(w_out, 1024, 1024, kb * 64, nb * 64, (unsigned char*)Wo_t, nb * 64, nb * 64 + 32, nullptr, 32.f, scr, lane); }
        }
        for (int i = gw * 64 + lane; i < 64 * 16 + 64 * 8; i += NGW * 64) {
            const bool big = i < 1024; const int j = big ? i : i - 1024, pos = big ? (j >> 4) : (j >> 3), f = big ? (j & 15) : (j & 7);
            float sn, cs; rope_cs((float)pos, f, big ? 0.0625f : 0.125f, sn, cs);
            float* tp = (big ? WSP(float, WS_ROPE16) : WSP(float, WS_ROPE8)) + 2 * j; tp[0] = cs; tp[1] = sn; }
        for (int i = gw * 64 + lane; i < 224 * 64; i += NGW * 64) *(u32x4*)((unsigned char*)Win_t + (size_t)1056 * 1024 + (size_t)i * 16) = (u32x4){0u, 0u, 0u, 0u};
        for (int m0 = gw * 4; m0 < T; m0 += NGW * 4) {
            f32x4 v[4][4];
#pragma unroll
            for (int r = 0; r < 4; ++r) { const f32x4* xr = (const f32x4*)(x + (size_t)(m0 + r) * DM) + lane;
#pragma unroll
                for (int j = 0; j < 4; ++j) v[r][j] = xr[64 * j]; }
#pragma unroll
            for (int r = 0; r < 4; ++r) { float s_ = 0.f;
#pragma unroll
                for (int j = 0; j < 4; ++j) s_ += (v[r][j][0] * v[r][j][0] + v[r][j][1] * v[r][j][1]) + (v[r][j][2] * v[r][j][2] + v[r][j][3] * v[r][j][3]);
                s_ = wave_sum(s_);
                if (lane == 0) RINV1[m0 + r] = 1.0f / sqrtf(s_ * (1.0f / DM) + EPS);
                unsigned* o4 = (unsigned*)((unsigned char*)XB + (size_t)(m0 + r) * DM) + lane;
#pragma unroll
                for (int j = 0; j < 4; ++j) { int t = __builtin_amdgcn_cvt_pk_fp8_f32(v[r][j][0], v[r][j][1], 0, false); t = __builtin_amdgcn_cvt_pk_fp8_f32(v[r][j][2], v[r][j][3], t, true); o4[64 * j] = (unsigned)t; } }
        }
        __syncthreads();
    }
    SEAM(0);
#if !MK_CG
    if (IN(0) && IN(1)) {
        const unsigned uni = __builtin_amdgcn_readfirstlane(bst[3]), rk = __builtin_amdgcn_readfirstlane(bst[2]);
        if (uni != 0u && rk < 32u && xbar.x < 8u) { xloc = true; bx = (int)(rk * 8u + xbar.x); vcu = (bx % 8) * (G / 8) + bx / 8; gw = vcu * 8 + wave; }
    }
#endif
    if (IN(1)) REPS(1) {
        PHASE_ARGS();
        pg8::Gemm g{WSP(bf16_t, WS_XB), WSP(bf16_t, WS_WIN), nullptr}; pg8::TileOrder<T, 4096, 0, 1> S; S.init(G, bx);
        pg8::EpiProj E{WSP(float, WS_RINV1), WSP(bf16_t, WS_LAT), WSP(float, WS_SSQ), WSP(bf16_t, WS_QB), WSP(bf16_t, WS_KB), WSP(bf16_t, WS_VB), WSP(unsigned char, WS_GATES), INP(3), INP(11), WSP(float, WS_ROPE16)};
        pg8::gemm_phase<1024, 1024, false, 1>(ldsl, g, S, E);
    }
    SEAM_L(1);
    if (IN(2)) REPS(2) {
        { PHASE_ARGS(); pg8::Gemm g{WSP(bf16_t, WS_LAT), WSP(bf16_t, WS_WQUP), nullptr}; pg8::TileOrder<T, 768, 0> S; S.init(G, bx); pg8::EpiQup E{WSP(float, WS_SSQ), WSP(bf16_t, WS_QA)}; pg8::gemm_phase<QL, LATW>(ldsl, g, S, E); }
        { PHASE_ARGS(); pg8::Gemm g{WSP(bf16_t, WS_LAT) + QL, WSP(bf16_t, WS_WKVUP), nullptr}; pg8::TileOrder<T, 1024, 0> S; S.init(G, bx); pg8::EpiKVup E{WSP(float, WS_SSQ), WSP(bf16_t, WS_LAT), INP(9), WSP(float, WS_ROPE8), WSP(bf16_t, WS_KA), WSP(bf16_t, WS_VA)}; pg8::gemm_phase<KVL, LATW>(ldsl, g, S, E); }
    }
    SEAM_L(2);
    if (IN(4)) REPS(4) {
        PHASE_ARGS();
        const bf16_t* Qa = WSP(bf16_t, WS_QA); const bf16_t* Ka = WSP(bf16_t, WS_KA); const bf16_t* Va = WSP(bf16_t, WS_VA); const bf16_t* Qb = WSP(bf16_t, WS_QB); const bf16_t* Kb = WSP(bf16_t, WS_KB); const bf16_t* Vb = WSP(bf16_t, WS_VB); unsigned char* Y8 = WSP(unsigned char, WS_XB);
        float mref96, mref64;
        { PHASE_TID(); const float* gq = INP(8); const float* gk = INP(9); const float* hq = INP(10); const float* hk = INP(11);
          float a = fmaxf(fabsf(gq[lane]), (lane < 32) ? fabsf(gq[64 + lane]) : 0.f), b = fmaxf(fabsf(gk[lane]), (lane < 32) ? fabsf(gk[64 + lane]) : 0.f), c = fabsf(hq[lane]), d = fabsf(hk[lane]);
#pragma unroll
          for (int o = 1; o < 64; o <<= 1) { a = fmaxf(a, __shfl_xor(a, o)); b = fmaxf(b, __shfl_xor(b, o)); c = fmaxf(c, __shfl_xor(c, o)); d = fmaxf(d, __shfl_xor(d, o)); }
          mref96 = __builtin_amdgcn_readfirstlane(__float_as_uint(1.02f * 9.797958971f * 1.4426950409f * a * b)); mref96 = __uint_as_float(__builtin_amdgcn_readfirstlane(__float_as_uint(1.02f * 9.797958971f * 1.4426950409f * a * b)));
          mref64 = __uint_as_float(__builtin_amdgcn_readfirstlane(__float_as_uint(1.02f * 8.0f * 1.4426950409f * c * d))); }
        const bool fast96 = mref96 <= 60.f, fast64 = mref64 <= 60.f;
#define ATT_MLA(bh_, qb_) do { const int b_ = (bh_) >> 3, h_ = (bh_) & 7; const bf16_t* q_ = Qa + ((size_t)(bh_) * SEQ + (qb_) * 256) * 96; const unsigned char* k_ = (const unsigned char*)Ka + (size_t)(bh_) * SEQ * 96; \
        const bf16_t* v_ = Va + (size_t)(bh_) * SEQ * 64; unsigned char* o_ = Y8 + ((size_t)b_ * SEQ + (qb_) * 256) * DM + h_ * 64; \
        if (fast96) att::attn_unit4<96, 1024, false>(q_, k_, v_, o_, SEQ, (LAS char*)ldsl, 0.f, INP(8), WSP(float, WS_ROPE8), (qb_) * 256); \
        else att::attn_unit4<96, 1024, true>(q_, k_, v_, o_, SEQ, (LAS char*)ldsl, -mref96, INP(8), WSP(float, WS_ROPE8), (qb_) * 256); } while (0)
#define ATT_GQA(bh_, qb_) do { const int b_ = (bh_) >> 3, h_ = (bh_) & 7, kvh_ = h_ >> 2; const bf16_t* q_ = Qb + ((size_t)(bh_) * SEQ + (qb_) * 256) * 64; const unsigned char* k_ = (const unsigned char*)Kb + (size_t)(b_ * 2 + kvh_) * SEQ * 64; \
        const bf16_t* v_ = Vb + (size_t)(b_ * 2 + kvh_) * SEQ * 64; unsigned char* o_ = Y8 + ((size_t)b_ * SEQ + (qb_) * 256) * DM + 512 + h_ * 64; \
        if (fast64) att::attn_unit4<64, 1024, false>(q_, k_, v_, o_, SEQ, (LAS char*)ldsl, 0.f, INP(10), WSP(float, WS_ROPE16), (qb_) * 256); \
        else att::attn_unit4<64, 1024, true>(q_, k_, v_, o_, SEQ, (LAS char*)ldsl, -mref64, INP(10), WSP(float, WS_ROPE16), (qb_) * 256); } while (0)
        if (G == 256) {
            const int xcd = bx % 8, v = bx / 8, slot = v >> 4, qb = v & 15;
            for (int r = 0; r < 4; ++r) ATT_MLA(xcd * 8 + 2 * r + slot, qb);
            for (int r = 0; r < 4; ++r) ATT_GQA(xcd * 8 + 2 * r + slot, qb);
        } else {
            for (int uix = bx; uix < 2048; uix += G) { const int r = uix & 1023; if (uix < 1024) ATT_MLA(r >> 4, r & 15); else ATT_GQA(r >> 4, r & 15); }
        }
#undef ATT_MLA
#undef ATT_GQA
    }
    SEAM_L(4);
    if (IN(5)) REPS(5) {
        PHASE_ARGS(); pg8::Gemm g{WSP(bf16_t, WS_XB), WSP(bf16_t, WS_WA), nullptr}; pg8::TileOrder<T, 1024, 0> S; S.init(G, bx); pg8::EpiMerge2 E{WSP(unsigned char, WS_GATES), WSP(unsigned char, WS_MG)};
        pg8::gemm_phase<1024, 1024, false, 1>(ldsl, g, S, E);
    }
    SEAM_L(5);
    if (IN(6)) REPS(6) {
        PHASE_ARGS();
        pg8::Gemm g{WSP(bf16_t, WS_MG), WSP(bf16_t, WS_WO), nullptr}; pg8::TileOrder<T, 1024, 0> S; S.init(G, bx); pg8::EpiOut E{INP(0), WSP(bf16_t, WS_X1H), WSP(unsigned char, WS_XB)};
        pg8::gemm_phase<1024, 1024, false, 1>(ldsl, g, S, E);
    }
    SEAM_L(6);
    if (IN(7)) REPS(7) {
        PHASE_TID(); PHASE_ARGS();
        const float* g_ffn = INP(15); const float* w_router = INP(16); const float* b_router = INP(17); const bf16_t* x1h = WSP(bf16_t, WS_X1H); float* AFF = WSP(float, WS_AFF); float* RINV2 = WSP(float, WS_RINV2);
        LAS float* WR = (LAS float*)ldsl;
        for (int i = tid; i < 1024 * 16; i += 512) { const int k = i >> 4, e = i & 15, rho = (k & ~31) | ((k & 7) << 2) | ((k >> 3) & 3); WR[rho * 16 + e] = g_ffn[k] * w_router[i]; }
        __syncthreads();
        const int li = lane & 15, kq = lane >> 4;
        const float be = b_router[li];
        for (int tile = gw; tile < T / 16; tile += NGW) {
            const int row0 = tile * 16;
            const u32x4* xp = (const u32x4*)(x1h + (size_t)(row0 + li) * DM) + kq;
            f32x4 acc = {0.f, 0.f, 0.f, 0.f}; float ss = 0.f;
            const LAS float* wl = WR + kq * 16 + li;
            u32x4 xa[8], xb[8];
#pragma unroll
            for (int q = 0; q < 8; ++q) xa[q] = xp[4 * q];
#pragma unroll 1
            for (int c = 0; c < 4; c += 2) {
#pragma unroll
                for (int q = 0; q < 8; ++q) xb[q] = xp[4 * ((c + 1) * 8 + q)];
#pragma unroll
                for (int q = 0; q < 8; ++q) { const int j = c * 8 + q; f32x4 f0, f1; unpack8_f16(xa[q], f0, f1);
#pragma unroll
                    for (int t = 0; t < 8; ++t) { const float a = (t < 4) ? f0[t & 3] : f1[t & 3]; ss += a * a; acc = __builtin_amdgcn_mfma_f32_16x16x4f32(a, wl[(32 * j + 4 * t) * 16], acc, 0, 0, 0); } }
                if (c + 2 < 4) {
#pragma unroll
                    for (int q = 0; q < 8; ++q) xa[q] = xp[4 * ((c + 2) * 8 + q)]; }
#pragma unroll
                for (int q = 0; q < 8; ++q) { const int j = (c + 1) * 8 + q; f32x4 f0, f1; unpack8_f16(xb[q], f0, f1);
#pragma unroll
                    for (int t = 0; t < 8; ++t) { const float a = (t < 4) ? f0[t & 3] : f1[t & 3]; ss += a * a; acc = __builtin_amdgcn_mfma_f32_16x16x4f32(a, wl[(32 * j + 4 * t) * 16], acc, 0, 0, 0); } }
            }
            ss += __shfl_xor(ss, 16); ss += __shfl_xor(ss, 32);
            const float ri = 1.0f / sqrtf(ss * (1.0f / DM) + EPS);
            if (kq == 0) RINV2[row0 + li] = ri;
#pragma unroll
            for (int r = 0; r < 4; ++r) {
                const int R = 4 * kq + r; const float rr = __shfl(ri, R);
                const float lg = acc[r] * rr + be;
                float mx = lg;
#pragma unroll
                for (int o = 1; o < 16; o <<= 1) mx = fmaxf(mx, __shfl_xor(mx, o));
                const float ex = __expf(lg - mx); float den = ex;
#pragma unroll
                for (int o = 1; o < 16; o <<= 1) den += __shfl_xor(den, o);
                const int m = row0 + R, b = m >> 12, s_ = m & 4095;
                AFF[((size_t)(b * 16 + li)) * SEQ + s_] = ex / den;
            }
        }
        __syncthreads();
    }
    SEAM_L(7);
    if (IN(8)) REPS(8) {
        PHASE_TID(); PHASE_ARGS();
        const float* g_ffn = INP(15); const float* w_eg = INP(18); const float* w_eu = INP(19); const float* w_ed = INP(20);
        const float* AFF = WSP(float, WS_AFF); const float* RINV2 = WSP(float, WS_RINV2); int* IDX = WSP(int, WS_IDX); float* GATEV = WSP(float, WS_GATEV); float* RG = WSP(float, WS_RG); int* INV = WSP(int, WS_INV);
        unsigned char* Wgu8 = WSP(unsigned char, WS_WGU); unsigned char* Wd8 = WSP(unsigned char, WS_WD);
        for (int p0_ = bx; p0_ < BATCH * NEXP; p0_ += G) {
            const int p = (G == 256) ? (p0_ % 8) * 16 + p0_ / 8 : p0_;
            LAS unsigned* keys = (LAS unsigned*)ldsl;
            LAS int* hist = (LAS int*)(ldsl + 16384);
            LAS int* scr = (LAS int*)(ldsl + 16384 + 1024);
            const int b = p >> 4, e = p & 15;
            const unsigned* ap = (const unsigned*)(AFF + (size_t)p * SEQ);
            for (int i = tid; i < SEQ; i += 512) keys[i] = ap[i];
            __syncthreads();
            unsigned prefix = 0u, pmask = 0u; int want = CAP;
            for (int pass = 0; pass < 4; ++pass) {
                const int shift = 24 - 8 * pass;
                if (tid < 256) hist[tid] = 0;
                __syncthreads();
                for (int i = tid; i < SEQ; i += 512) { const unsigned k = keys[i]; if ((k & pmask) == prefix) atomicAdd((int*)&hist[(k >> shift) & 255u], 1); }
                __syncthreads();
                if (tid < 64) {
                    const int c0 = hist[255 - 4 * tid], c1 = hist[254 - 4 * tid], c2 = hist[253 - 4 * tid], c3 = hist[252 - 4 * tid]; const int sm = (c0 + c1) + (c2 + c3);
                    int inc = sm;
#pragma unroll
                    for (int o = 1; o < 64; o <<= 1) { const int y = __shfl_up(inc, o); if (tid >= o) inc += y; }
                    const int exc = inc - sm;
                    if (exc < want && want <= inc) { int cum = exc, d = 255 - 4 * tid;
                        if (cum + c0 < want) { cum += c0; --d; if (cum + c1 < want) { cum += c1; --d; if (cum + c2 < want) { cum += c2; --d; } } }
                        scr[16] = d; scr[17] = want - cum; }
                }
                __syncthreads();
                const int d = scr[16]; want = scr[17];
                prefix |= ((unsigned)d) << shift; pmask |= 255u << shift;
                __syncthreads();
            }
            const unsigned thr = prefix; const int need_eq = want;
            unsigned kv[8]; int ceq = 0;
#pragma unroll
            for (int j = 0; j < 8; ++j) { kv[j] = keys[tid * 8 + j]; ceq += (kv[j] == thr) ? 1 : 0; }
            int toteq; int eqbase = block_scan(ceq, toteq, scr, tid);
            int csel = 0; unsigned selmask = 0u;
#pragma unroll
            for (int j = 0; j < 8; ++j) { bool sel = kv[j] > thr; if (kv[j] == thr) { sel = eqbase < need_eq; ++eqbase; } if (sel) { selmask |= 1u << j; ++csel; } }
            int totsel; int slot = block_scan(csel, totsel, scr, tid);
#pragma unroll
            for (int j = 0; j < 8; ++j) { const int s = tid * 8 + j; int iv = -1;
                if (selmask & (1u << j)) { iv = slot; IDX[(e * 8 + b) * CAP + slot] = b * SEQ + s; GATEV[(size_t)(e * 8 + b) * CAP + slot] = __uint_as_float(kv[j]); RG[(size_t)(e * 8 + b) * CAP + slot] = RINV2[b * SEQ + s]; ++slot; }
                INV[((size_t)b * SEQ + s) * 16 + e] = iv; }
            __syncthreads();
        }
        { LAS float* scr = (LAS float*)(ldsl + wave * 16640);
          constexpr int IPM = 16 * 16;
          const bool fastb = (G == 256) && (bx >= 128); const int widx = (G == 256) ? ((fastb ? bx - 128 : bx) * 8 + wave) : gw;
          const int ibase = (G == 256) ? (fastb ? 0 : 7168) : 0, istep = (G == 256) ? 1024 : NGW, iend = (G == 256) ? (fastb ? 7168 : 48 * IPM) : 48 * IPM;
          for (int it = ibase + widx; it < iend; it += istep) {
              const int mtx = it / IPM, r = it % IPM, kb = r / 16, nb = r % 16, e = mtx % 16, kind = mtx / 16, n0 = nb * 64;
              if (kind == 0)      tr_item64_f8(w_eg + (size_t)e * DM * FF, 1024, 1024, kb * 64, n0, Wgu8 + (size_t)e * 2048 * 1024, (n0 >> 7) * 256 + (n0 & 127), (n0 >> 7) * 256 + (n0 & 127) + 32, g_ffn, 64.f, scr, lane);
              else if (kind == 1) tr_item64_f8(w_eu + (size_t)e * DM * FF, 1024, 1024, kb * 64, n0, Wgu8 + (size_t)e * 2048 * 1024, (n0 >> 7) * 256 + 128 + (n0 & 127), (n0 >> 7) * 256 + 128 + (n0 & 127) + 32, g_ffn, 64.f, scr, lane);
              else                tr_item64_f8(w_ed + (size_t)e * FF * DM, 1024, 1024, kb * 64, n0, Wd8 + (size_t)e * 1024 * 1024, n0, n0 + 32, nullptr, 64.f, scr, lane);
          } }
        __syncthreads();
    }
    SEAM(8);
    if (IN(10)) REPS(10) {
        PHASE_ARGS();
        pg8::Gemm g{WSP(bf16_t, WS_XB), WSP(bf16_t, WS_WGU), WSP(int, WS_IDX)};
        pg8::TileOrder<NEXP * BATCH * CAP, 2048, 16> S; S.init(G, bx); pg8::EpiSwiGLU E{WSP(float, WS_RG), WSP(unsigned char, WS_ACT)};
        pg8::gemm_phase<1024, 1024, true, 1>(ldsl, g, S, E);
    }
    SEAM_L(10);
    if (IN(11)) REPS(11) {
        PHASE_ARGS();
        pg8::Gemm g{WSP(bf16_t, WS_ACT), WSP(bf16_t, WS_WD), nullptr}; pg8::TileOrder<NEXP * BATCH * CAP, 1024, 16> S; S.init(G, bx); pg8::EpiDown E{WSP(float, WS_GATEV), WSP(unsigned char, WS_XE)};
        pg8::gemm_phase<1024, 1024, false, 1>(ldsl, g, S, E);
    }
    SEAM(11);
    if (IN(12)) REPS(12) {
        PHASE_TID(); PHASE_ARGS();
        const int* INV = WSP(int, WS_INV); const unsigned char* YE = WSP(unsigned char, WS_XE); float* out = KA_->out; const bf16_t* x1h = WSP(bf16_t, WS_X1H);
        for (int m0 = gw * 2; m0 < T; m0 += NGW * 2) {
            const int b = m0 >> 12;
            int myinv[2]; f32x4 ac[2][4]; unsigned long long mask[2];
#pragma unroll
            for (int r = 0; r < 2; ++r) { const int m = m0 + r; myinv[r] = (lane < 16) ? INV[(size_t)m * 16 + lane] : -1; const bf16_t* xrow = x1h + (size_t)m * DM;
                unpack8_f16(*(const u32x4*)(xrow + lane * 8), ac[r][0], ac[r][1]); unpack8_f16(*(const u32x4*)(xrow + 512 + lane * 8), ac[r][2], ac[r][3]); }
#pragma unroll
            for (int r = 0; r < 2; ++r) mask[r] = __ballot(myinv[r] >= 0);
            while (mask[0] | mask[1]) {
                u32x2 y[2][2][2]; int cnt[2] = {0, 0};
#pragma unroll
                for (int r = 0; r < 2; ++r)
#pragma unroll
                    for (int q = 0; q < 2; ++q) { if (mask[r]) { const int e = __builtin_ctzll(mask[r]); mask[r] &= mask[r] - 1; const int sl = __shfl(myinv[r], e);
                            const unsigned char* yr = YE + ((size_t)(e * 8 + b) * CAP + sl) * DM; y[r][q][0] = *(const u32x2*)(yr + lane * 8); y[r][q][1] = *(const u32x2*)(yr + 512 + lane * 8); cnt[r] = q + 1; } }
#pragma unroll
                for (int r = 0; r < 2; ++r)
#pragma unroll
                    for (int q = 0; q < 2; ++q) { if (q < cnt[r]) { f32x4 y0, y1, y2, y3; unpack8_fp8(y[r][q][0], y0, y1); unpack8_fp8(y[r][q][1], y2, y3);
                            ac[r][0] += y0 * 0.015625f; ac[r][1] += y1 * 0.015625f; ac[r][2] += y2 * 0.015625f; ac[r][3] += y3 * 0.015625f; } }
            }
#pragma unroll
            for (int r = 0; r < 2; ++r) { float* orow = out + (size_t)(m0 + r) * DM;
                if (PROBE_PH == 12 && rp_ + 1 < PROBE_REPS) orow = WSP(float, WS_ACT) + (size_t)(m0 + r) * DM;
                *(f32x4*)(orow + lane * 8) = ac[r][0]; *(f32x4*)(orow + lane * 8 + 4) = ac[r][1]; *(f32x4*)(orow + 512 + lane * 8) = ac[r][2]; *(f32x4*)(orow + 512 + lane * 8 + 4) = ac[r][3]; }
        }
    }
#undef IN
#undef SEAM
#undef SEAM_L
}


extern "C" void kernel_launch(void* const* d_in, const int* in_sizes, int n_in, void* d_out, int out_size, void* d_ws, size_t ws_size, hipStream_t stream) {
    static int grid = 0;
    if (grid == 0) {
        if (n_in != 21 || in_sizes[0] != T * DM || out_size != T * DM || ws_size < WS_END) {
            fprintf(stderr, "kernel_launch: unexpected shapes: n_in %d in0 %d out %d ws %zu (need >= %zu)\n", n_in, n_in > 0 ? in_sizes[0] : -1, out_size, ws_size, (size_t)WS_END); grid = -1; return; }
        int dev = 0, cus = 0, per_cu = 0;
        if (hipGetDevice(&dev) != hipSuccess || hipDeviceGetAttribute(&cus, hipDeviceAttributeMultiprocessorCount, dev) != hipSuccess) { grid = -1; return; }
        if (hipFuncSetAttribute((const void*)fwd_kernel, hipFuncAttributeMaxDynamicSharedMemorySize, LDS_BYTES) != hipSuccess) { fprintf(stderr, "kernel_launch: hipFuncSetAttribute failed\n"); grid = -1; return; }
        if (hipOccupancyMaxActiveBlocksPerMultiprocessor(&per_cu, (const void*)fwd_kernel, 512, LDS_BYTES) != hipSuccess || per_cu < 1) { fprintf(stderr, "kernel_launch: occupancy query gave %d\n", per_cu); per_cu = 1; }
        (void)hipGetLastError();
        grid = cus;
    }
    if (grid < 0) return;
    Args a{};
    for (int i = 0; i < 21; ++i) a.in[i] = (const float*)d_in[i];
    a.out = (float*)d_out; a.ws = (unsigned char*)d_ws;
#if MK_MULTI
    for (int p = 0; p < NPH; ++p) { a.ph_lo = p; a.ph_hi = p + 1; hipLaunchKernelGGL(fwd_kernel, dim3(grid), dim3(512), LDS_BYTES, stream, a); }
#elif MK_CG
    a.ph_lo = 0; a.ph_hi = NPH;
    void* kargs[] = {&a};
    hipError_t e = hipLaunchCooperativeKernel((const void*)fwd_kernel, dim3(grid), dim3(512), kargs, LDS_BYTES, stream);
    if (e != hipSuccess) fprintf(stderr, "kernel_launch: cooperative launch failed: %s (grid %d)\n", hipGetErrorString(e), grid);
#else
    a.ph_lo = 0; a.ph_hi = NPH;
    if (hipMemsetAsync((char*)d_ws + WS_CTL, 0, CTL_ZERO_BYTES, stream) != hipSuccess) { fprintf(stderr, "kernel_launch: memset of the barrier words failed\n"); return; }
    hipLaunchKernelGGL(fwd_kernel, dim3(grid), dim3(512), LDS_BYTES, stream, a);
#endif
}
```

```cpp
#include <hip/hip_runtime.h>
#include <hip/hip_bf16.h>
#include <hip/hip_cooperative_groups.h>
#include <cstdio>
#include <cstdint>
namespace cg = cooperative_groups;

#ifndef MK_CG
#define MK_CG 0
#endif
#ifndef PROBE_PH
#define PROBE_PH -1
#define PROBE_REPS 1
#endif
#define REPS(k) for (int rp_ = 0; rp_ < ((k) == PROBE_PH ? PROBE_REPS : 1); ++rp_)
#ifndef MK_MULTI
#define MK_MULTI 0
#endif

constexpr int BATCH = 8, SEQ = 4096, DM = 1024, T = BATCH * SEQ;
constexpr int QL = 768, KVL = 256, LATW = 1056;
constexpr int NEXP = 16, CAP = 512, FF = 1024;
constexpr float EPS = 1e-6f;
constexpr int NPH = 13;

#define LAS __attribute__((address_space(3)))
#define GAS __attribute__((address_space(1)))
typedef unsigned short bf16_t;
typedef short bf16x8 __attribute__((ext_vector_type(8)));
typedef float f32x4 __attribute__((ext_vector_type(4)));
typedef float f32x2 __attribute__((ext_vector_type(2)));
typedef float f32x16 __attribute__((ext_vector_type(16)));
typedef unsigned u32x4 __attribute__((ext_vector_type(4)));
typedef unsigned u32x2 __attribute__((ext_vector_type(2)));
typedef short s16x4 __attribute__((ext_vector_type(4)));

__device__ __forceinline__ unsigned cvt_pk_bf16(float lo, float hi) { unsigned r; asm volatile("v_cvt_pk_bf16_f32 %0, %1, %2" : "=v"(r) : "v"(lo), "v"(hi)); return r; }
__device__ __forceinline__ u32x4 pack8(f32x4 a, f32x4 b) { u32x4 w; w.x = cvt_pk_bf16(a[0], a[1]); w.y = cvt_pk_bf16(a[2], a[3]); w.z = cvt_pk_bf16(b[0], b[1]); w.w = cvt_pk_bf16(b[2], b[3]); return w; }
__device__ __forceinline__ float bf_lo(unsigned w) { return __uint_as_float(w << 16); }
__device__ __forceinline__ float bf_hi(unsigned w) { return __uint_as_float(w & 0xffff0000u); }
__device__ __forceinline__ void unpack8(u32x4 w, f32x4& a, f32x4& b) { a[0] = bf_lo(w.x); a[1] = bf_hi(w.x); a[2] = bf_lo(w.y); a[3] = bf_hi(w.y); b[0] = bf_lo(w.z); b[1] = bf_hi(w.z); b[2] = bf_lo(w.w); b[3] = bf_hi(w.w); }
__device__ __forceinline__ u32x2 pack8_fp8(f32x4 a, f32x4 b) { u32x2 w; int t = __builtin_amdgcn_cvt_pk_fp8_f32(a[0], a[1], 0, false); t = __builtin_amdgcn_cvt_pk_fp8_f32(a[2], a[3], t, true); w.x = (unsigned)t;
    t = __builtin_amdgcn_cvt_pk_fp8_f32(b[0], b[1], 0, false); t = __builtin_amdgcn_cvt_pk_fp8_f32(b[2], b[3], t, true); w.y = (unsigned)t; return w; }
__device__ __forceinline__ void unpack8_fp8(u32x2 w, f32x4& a, f32x4& b) {
    const f32x2 p0 = __builtin_amdgcn_cvt_pk_f32_fp8((int)w.x, false), p1 = __builtin_amdgcn_cvt_pk_f32_fp8((int)w.x, true), p2 = __builtin_amdgcn_cvt_pk_f32_fp8((int)w.y, false), p3 = __builtin_amdgcn_cvt_pk_f32_fp8((int)w.y, true);
    a[0] = p0[0]; a[1] = p0[1]; a[2] = p1[0]; a[3] = p1[1]; b[0] = p2[0]; b[1] = p2[1]; b[2] = p3[0]; b[3] = p3[1]; }
__device__ __forceinline__ int vt_pos(int s) { const int k = s & 15; return (s & ~15) | (((k >> 2) & 1) << 3) | ((k >> 3) << 2) | (k & 3); }
__device__ __forceinline__ void store_vt(bf16_t* vt, int d0, int s, f32x4 a0, f32x4 a1, f32x4 c0, f32x4 c1) {
    const bool odd = s & 1;
    bf16_t* p = vt + (size_t)(d0 + (odd ? 4 : 0)) * SEQ + (vt_pos(s) & ~1);
    const u32x4 wa = pack8(a0, a1), wc = pack8(c0, c1);
#define VT_PAIR(W, POFF) do { const unsigned k0_ = odd ? W.z : W.x, k1_ = odd ? W.w : W.y, s0_ = odd ? W.x : W.z, s1_ = odd ? W.y : W.w; \
        const unsigned r0_ = (unsigned)__builtin_amdgcn_mov_dpp((int)s0_, 0xB1, 0xF, 0xF, true), r1_ = (unsigned)__builtin_amdgcn_mov_dpp((int)s1_, 0xB1, 0xF, 0xF, true); \
        const unsigned e0_ = odd ? r0_ : k0_, o0_ = odd ? k0_ : r0_, e1_ = odd ? r1_ : k1_, o1_ = odd ? k1_ : r1_;        \
        unsigned* q_ = (unsigned*)(p + (size_t)(POFF) * SEQ); \
        q_[0] = (e0_ & 0xffffu) | (o0_ << 16); q_[SEQ / 2] = (e0_ >> 16) | (o0_ & 0xffff0000u); q_[SEQ] = (e1_ & 0xffffu) | (o1_ << 16); q_[SEQ + SEQ / 2] = (e1_ >> 16) | (o1_ & 0xffff0000u); } while (0)
    VT_PAIR(wa, 0); VT_PAIR(wc, 32);
#undef VT_PAIR
}
typedef _Float16 h16x8 __attribute__((ext_vector_type(8)));
typedef float f32x8v __attribute__((ext_vector_type(8)));
__device__ __forceinline__ u32x4 pack8_f16(f32x4 a, f32x4 b) { const f32x8v v = {a[0], a[1], a[2], a[3], b[0], b[1], b[2], b[3]}; return __builtin_bit_cast(u32x4, __builtin_convertvector(v, h16x8)); }
__device__ __forceinline__ u32x2 pack4_f16(f32x4 a) { typedef _Float16 h16x4 __attribute__((ext_vector_type(4))); return __builtin_bit_cast(u32x2, __builtin_convertvector(a, h16x4)); }
__device__ __forceinline__ void unpack8_f16(u32x4 w, f32x4& a, f32x4& b) { const f32x8v v = __builtin_convertvector(__builtin_bit_cast(h16x8, w), f32x8v); a = (f32x4){v[0], v[1], v[2], v[3]}; b = (f32x4){v[4], v[5], v[6], v[7]}; }
__device__ __forceinline__ float sigmoidf_(float x) { return __builtin_amdgcn_rcpf(1.f + __builtin_amdgcn_exp2f(-1.4426950408889634f * x)); }

__device__ __forceinline__ void rope_cs(float pos, int fi, float nf_inv, float& s, float& c) {
    const float inv = __builtin_amdgcn_exp2f(-(float)fi * nf_inv * 13.287712379549449f);
    const float rev = pos * inv * 0.15915494309189535f; const float fr = rev - floorf(rev);
    s = __builtin_amdgcn_sinf(fr); c = __builtin_amdgcn_cosf(fr);
}
__device__ __forceinline__ f32x4 rope4t(f32x4 v, f32x4 cs) {
    f32x4 r; r[0] = v[0] * cs[0] - v[1] * cs[1]; r[1] = v[0] * cs[1] + v[1] * cs[0]; r[2] = v[2] * cs[2] - v[3] * cs[3]; r[3] = v[2] * cs[3] + v[3] * cs[2]; return r;
}
__device__ __forceinline__ f32x4 rope4(f32x4 v, float pos, int f0, float nf_inv) {
    float s0, c0, s1, c1; rope_cs(pos, f0, nf_inv, s0, c0); rope_cs(pos, f0 + 1, nf_inv, s1, c1);
    f32x4 r; r[0] = v[0] * c0 - v[1] * s0; r[1] = v[0] * s0 + v[1] * c0; r[2] = v[2] * c1 - v[3] * s1; r[3] = v[2] * s1 + v[3] * c1; return r;
}

namespace pg8 {
constexpr int BM = 256, BK = 64, HALF = 128, HTB = HALF * BK * 2, STAGE_BYTES = 8 * HTB, NXCD = 8, WGM = 8;
__host__ __device__ __forceinline__ int lds_byte(int r, int c) { const int st = (r >> 4) * 2 + (c >> 5), rr = r & 15, cc = c & 31, ob = rr * 64 + cc * 2; return st * 1024 + (ob ^ (((ob >> 9) & 1) << 5)); }
__host__ __device__ __forceinline__ void stage_rc(int b, int& R, int& C) { const int st = b / 1024, sb = b % 1024, swz = sb ^ (((sb >> 9) & 1) << 5); R = (st >> 1) * 16 + swz / 64; C = (st & 1) * 32 + (swz % 64) / 2; }
__host__ __device__ __forceinline__ int perm32(int rho) { const int n = rho >> 4, i = rho & 15; return 8 * (i >> 2) + 4 * n + (i & 3); }

struct Unit { int pm, pn, pb; };
struct Gemm { const bf16_t* A; const bf16_t* Bt; const int* rowmap; };

template <int M, int N, int BDIV, int FLIP = 0> struct TileOrder {
    static constexpr int nM = M / BM, nN = N / BM, nwg = nM * nN;
    int G, c;
    __device__ __forceinline__ void init(int G_, int c_) { G = G_; c = c_; }
    __device__ __forceinline__ bool next(int i, Unit& u) const {
        const int L = i * G + c; if (L >= nwg) return false;
        int wgid = L; { constexpr int q = nwg / NXCD, r = nwg % NXCD; const int xcd = wgid % NXCD, off = wgid / NXCD; wgid = (xcd < r ? xcd * (q + 1) : r * (q + 1) + (xcd - r) * q) + off; }
        constexpr int nig = WGM * nN; const int gid = wgid / nig, fm = gid * WGM, gsz = (nM - fm) < WGM ? (nM - fm) : WGM;
        u.pm = fm + ((wgid % nig) % gsz); u.pn = (wgid % nig) / gsz; if (FLIP && G == 256 && (i & 4)) u.pn ^= 3; u.pb = (BDIV ? (u.pm / (BDIV ? BDIV : 1)) * nN : 0) + u.pn; return true;
    }
};

typedef int v4i_t __attribute__((ext_vector_type(4)));
typedef int v8i_t __attribute__((ext_vector_type(8)));
template <int K, int LDA, bool GATHER = false, int ES = 2, class Epi, class Sched>
__device__ __forceinline__ void gemm_phase(LAS unsigned char* lds, const Gemm g, const Sched& S, const Epi& E) {
    int tid = threadIdx.x; asm volatile("" : "+v"(tid));
    const int wid = __builtin_amdgcn_readfirstlane(tid >> 6), lane = tid & 63, wr = wid >> 2, wc = wid & 3, fr = lane & 15, fq = lane >> 4;
    constexpr int nt = K * ES / (BK * 2), lda = LDA; static_assert((K * ES) % 256 == 0 && K * ES >= 512, "K bytes: multiple of 256, >= 512");
    unsigned voffA[2], voffB[2]; int gR[2]; unsigned gC[2];
#pragma unroll
    for (int i = 0; i < 2; ++i) { int R, C; stage_rc(tid * 16 + i * 8192, R, C); const int Rb = (R & ~31) + perm32(R & 31);
        voffA[i] = (unsigned)(R * lda * ES + C * 2); voffB[i] = (unsigned)(Rb * K * ES + C * 2); gR[i] = R; gC[i] = (unsigned)C * 2u; }
    unsigned cof[2][2], nof[2][2];
#define PG8_GOFF(dst, pm_) do { _Pragma("unroll") for (int h_ = 0; h_ < 2; ++h_) _Pragma("unroll") for (int i_ = 0; i_ < 2; ++i_) \
        dst[h_][i_] = (unsigned)g.rowmap[(pm_) * BM + h_ * HALF + gR[i_]] * (unsigned)(lda * ES) + gC[i_]; } while (0)
    constexpr size_t kstep = (size_t)(BK * 2);
    constexpr size_t hstepA = (size_t)HALF * lda * ES, hstepB = (size_t)HALF * K * ES;
    constexpr size_t tstepA = 2 * hstepA, tstepB = 2 * hstepB;
    const unsigned ldsw = (unsigned)wid * 1024u;
    const int aoff = lds_byte(wr * 64 + fr, fq * 8), boff = lds_byte(wc * 32 + fr, fq * 8);
#define PG8_SA(b, h) (((b) * 2 + (h)) * HTB)
#define PG8_SB(b, h) ((4 + (b) * 2 + (h)) * HTB)
#define PG8_STAGE(bufoff, gbase, voff) do { _Pragma("unroll") for (int _i = 0; _i < 2; ++_i) \
        __builtin_amdgcn_global_load_lds((const unsigned*)((const char*)(gbase) + (voff)[_i]), (LAS unsigned*)(lds + (bufoff) + ldsw + _i * 8192), 16, 0, 0); } while (0)
#define PG8_STAGE1(bufoff, gbase, voff0, rowbytes) do { _Pragma("unroll") for (int _i = 0; _i < 2; ++_i) \
        __builtin_amdgcn_global_load_lds((const unsigned*)((const char*)(gbase) + (size_t)_i * 64 * (rowbytes) + (voff0)), (LAS unsigned*)(lds + (bufoff) + ldsw + _i * 8192), 16, 0, 0); } while (0)
#define PG8_LDA(dst, b, h) do { _Pragma("unroll") for (int m = 0; m < 4; ++m) { \
        if constexpr (ES == 2) { _Pragma("unroll") for (int k = 0; k < 2; ++k) dst[m][k] = *(const LAS bf16x8*)(lds + PG8_SA(b, h) + aoff + m * 2048 + k * 1024); } \
        else { dst##8[m] = __builtin_shufflevector(*(const LAS v4i_t*)(lds + PG8_SA(b, h) + aoff + m * 2048), *(const LAS v4i_t*)(lds + PG8_SA(b, h) + aoff + m * 2048 + 1024), 0, 1, 2, 3, 4, 5, 6, 7); } } } while (0)
#define PG8_LDB(dst, b, h) do { _Pragma("unroll") for (int n = 0; n < 2; ++n) { \
        if constexpr (ES == 2) { _Pragma("unroll") for (int k = 0; k < 2; ++k) dst[n][k] = *(const LAS bf16x8*)(lds + PG8_SB(b, h) + boff + n * 2048 + k * 1024); } \
        else { dst##8[n] = __builtin_shufflevector(*(const LAS v4i_t*)(lds + PG8_SB(b, h) + boff + n * 2048), *(const LAS v4i_t*)(lds + PG8_SB(b, h) + boff + n * 2048 + 1024), 0, 1, 2, 3, 4, 5, 6, 7); } } } while (0)
#define PG8_MMA(ai, bj, At, Bt) do { __builtin_amdgcn_s_setprio(1); _Pragma("unroll") for (int m = 0; m < 4; ++m) _Pragma("unroll") for (int n = 0; n < 2; ++n) { \
        if constexpr (ES == 2) { _Pragma("unroll") for (int k = 0; k < 2; ++k) acc[ai][bj][m][n] = __builtin_amdgcn_mfma_f32_16x16x32_bf16(Bt[n][k], At[m][k], acc[ai][bj][m][n], 0, 0, 0); } \
        else { asm volatile("v_mfma_scale_f32_16x16x128_f8f6f4 %0, %1, %2, %0, %3, %3 op_sel_hi:[0,0,0]" : "+v"(acc[ai][bj][m][n]) : "v"(Bt##8[n]), "v"(At##8[m]), "v"(one_scale)); } } \
        __builtin_amdgcn_s_setprio(0); } while (0)
#define PG8_MMA_Z(ai, bj, At, Bt) do { __builtin_amdgcn_s_setprio(1); _Pragma("unroll") for (int m = 0; m < 4; ++m) _Pragma("unroll") for (int n = 0; n < 2; ++n) { \
        asm volatile("v_mfma_scale_f32_16x16x128_f8f6f4 %0, %1, %2, 0, %3, %3 op_sel_hi:[0,0,0]" : "=&v"(acc[ai][bj][m][n]) : "v"(Bt##8[n]), "v"(At##8[m]), "v"(one_scale)); } \
        __builtin_amdgcn_s_setprio(0); } while (0)
#define PG8_MMA2(ai, At, zero_) do { if (ES == 1 && (zero_)) { PG8_MMA_Z(ai, 0, At, B0); PG8_MMA_Z(ai, 1, At, B1); } else { PG8_MMA(ai, 0, At, B0); PG8_MMA(ai, 1, At, B1); } } while (0)
#define PG8_WAIT_V(n) asm volatile("s_waitcnt vmcnt(" #n ")" ::: "memory")
#define PG8_WAIT_V8E(first) do { if (first) asm volatile("s_waitcnt vmcnt(%0)" :: "n"(8 + Epi::NSE) : "memory"); else asm volatile("s_waitcnt vmcnt(8)" ::: "memory"); } while (0)
#define PG8_WAIT_L(n) asm volatile("s_waitcnt lgkmcnt(" #n ")" ::: "memory")
#define PG8_BAR __builtin_amdgcn_s_barrier()
#define PG8_SCHED __builtin_amdgcn_sched_barrier(0)
    Unit cur, nxt; int ui = 0;
    if (!S.next(0, cur)) return;
    f32x4 acc[2][2][4][2];
    if constexpr (ES == 2)
#pragma unroll
    for (int a = 0; a < 2; ++a)
#pragma unroll
        for (int b = 0; b < 2; ++b)
#pragma unroll
            for (int m = 0; m < 4; ++m)
#pragma unroll
                for (int n = 0; n < 2; ++n) acc[a][b][m][n] = (f32x4){0.f, 0.f, 0.f, 0.f};
    bf16x8 At[4][2], B0[2][2], B1[2][2]; v8i_t At8[4], B08[2], B18[2];
    const int one_scale = 0x7f7f7f7f;
    const char* cA = GATHER ? (const char*)g.A : (const char*)g.A + (size_t)cur.pm * tstepA; const char* cB = (const char*)g.Bt + (size_t)cur.pb * tstepB;
    if constexpr (GATHER) { PG8_GOFF(cof, cur.pm); }
    PG8_STAGE1(PG8_SB(0, 0), cB, voffB[0], K * ES); PG8_STAGE1(PG8_SB(0, 1), cB + hstepB, voffB[0], K * ES);
    if constexpr (GATHER) { PG8_STAGE(PG8_SA(0, 0), cA, cof[0]); PG8_STAGE(PG8_SA(0, 1), cA, cof[1]); } else { PG8_STAGE1(PG8_SA(0, 0), cA, voffA[0], lda * ES); PG8_STAGE1(PG8_SA(0, 1), cA + hstepA, voffA[0], lda * ES); }
    if (wr == 1) PG8_BAR;
    PG8_WAIT_V(2); PG8_BAR;
    PG8_STAGE1(PG8_SB(1, 0), cB + kstep, voffB[0], K * ES);
    if constexpr (GATHER) { PG8_STAGE(PG8_SA(1, 0), cA + kstep, cof[0]); } else { PG8_STAGE1(PG8_SA(1, 0), cA + kstep, voffA[0], lda * ES); }
    PG8_STAGE1(PG8_SB(1, 1), cB + hstepB + kstep, voffB[0], K * ES);
    PG8_WAIT_V(6); PG8_BAR;
    for (;;) {
        const bool has_next = S.next(ui + 1, nxt);
        const char* nA = GATHER ? cA : (has_next ? (const char*)g.A + (size_t)nxt.pm * tstepA : cA); const char* nB = has_next ? (const char*)g.Bt + (size_t)nxt.pb * tstepB : cB;
        if constexpr (GATHER) { if (has_next) { PG8_GOFF(nof, nxt.pm); } else {
#pragma unroll
            for (int h_ = 0; h_ < 2; ++h_) { nof[h_][0] = cof[h_][0]; nof[h_][1] = cof[h_][1]; } } }
#pragma unroll 1
        for (int t = 0; t < nt; t += 2) {
            const bool last = (t == nt - 2);
            const char* a1 = cA + (size_t)(t + 1) * kstep;
            const char* a2 = last ? nA : cA + (size_t)(t + 2) * kstep; const char* b2 = last ? nB : cB + (size_t)(t + 2) * kstep;
            const char* a3 = a2 + kstep; const char* b3 = b2 + kstep;
            unsigned sel0[2], sel1[2];
            if constexpr (GATHER) { sel0[0] = last ? nof[0][0] : cof[0][0]; sel0[1] = last ? nof[0][1] : cof[0][1]; sel1[0] = last ? nof[1][0] : cof[1][0]; sel1[1] = last ? nof[1][1] : cof[1][1]; }
            PG8_LDB(B0, 0, 0); PG8_LDB(B1, 0, 1); PG8_SCHED; PG8_LDA(At, 0, 0);
            if constexpr (GATHER) { PG8_STAGE(PG8_SA(1, 1), a1, cof[1]); } else { PG8_STAGE1(PG8_SA(1, 1), a1 + hstepA, voffA[0], lda * ES); }
            const bool after_epi = (t == 0) && (ui > 0);
            PG8_WAIT_V8E(after_epi); PG8_WAIT_L(0); PG8_BAR; PG8_MMA2(0, At, t == 0); PG8_BAR; PG8_SCHED;
            PG8_LDA(At, 0, 1); PG8_STAGE1(PG8_SB(0, 0), b2, voffB[0], K * ES); PG8_STAGE1(PG8_SB(0, 1), b2 + hstepB, voffB[0], K * ES);
            if constexpr (GATHER) { PG8_STAGE(PG8_SA(0, 0), a2, sel0); } else { PG8_STAGE1(PG8_SA(0, 0), a2, voffA[0], lda * ES); }
            PG8_WAIT_V8E(after_epi); PG8_WAIT_L(0); PG8_BAR; PG8_MMA2(1, At, t == 0); PG8_BAR; PG8_SCHED;
            PG8_LDB(B0, 1, 0); PG8_LDB(B1, 1, 1); PG8_SCHED; PG8_LDA(At, 1, 0);
            if constexpr (GATHER) { PG8_STAGE(PG8_SA(0, 1), a2, sel1); } else { PG8_STAGE1(PG8_SA(0, 1), a2 + hstepA, voffA[0], lda * ES); }
            PG8_WAIT_V(8); PG8_WAIT_L(0); PG8_BAR; PG8_MMA(0, 0, At, B0); PG8_MMA(0, 1, At, B1); PG8_BAR; PG8_SCHED;
            PG8_LDA(At, 1, 1); PG8_STAGE1(PG8_SB(1, 0), b3, voffB[0], K * ES); PG8_STAGE1(PG8_SB(1, 1), b3 + hstepB, voffB[0], K * ES);
            if constexpr (GATHER) { PG8_STAGE(PG8_SA(1, 0), a3, sel0); } else { PG8_STAGE1(PG8_SA(1, 0), a3, voffA[0], lda * ES); }
            PG8_WAIT_V(8); PG8_WAIT_L(0); PG8_BAR; PG8_MMA(1, 0, At, B0); PG8_MMA(1, 1, At, B1); PG8_BAR; PG8_SCHED;
            if constexpr (Epi::MIDT > 0) { if (t + 2 == Epi::MIDT) { if constexpr (ES == 1) asm volatile("s_nop 15\n\ts_nop 15" ::: "memory"); E.mid(acc, cur, wr, wc, fr, fq); if constexpr (ES == 1) asm volatile("s_nop 7" ::: "memory"); } }
        }
        if (wr == 0) PG8_BAR;
        if constexpr (ES == 1) asm volatile("s_nop 15\n\ts_nop 15" ::: "memory");
        E(acc, cur, wr, wc, fr, fq);
        if (!has_next) break;
        if constexpr (ES == 2)
#pragma unroll
        for (int a = 0; a < 2; ++a)
#pragma unroll
            for (int b = 0; b < 2; ++b)
#pragma unroll
                for (int m = 0; m < 4; ++m)
#pragma unroll
                    for (int n = 0; n < 2; ++n) acc[a][b][m][n] = (f32x4){0.f, 0.f, 0.f, 0.f};
        cur = nxt; cA = nA; cB = nB; ++ui;
        if constexpr (GATHER) {
#pragma unroll
            for (int h_ = 0; h_ < 2; ++h_) { cof[h_][0] = nof[h_][0]; cof[h_][1] = nof[h_][1]; } }
        if (wr == 1) PG8_BAR;
    }
    PG8_WAIT_V(0);
    PG8_BAR;
#undef PG8_GOFF
#undef PG8_SA
#undef PG8_SB
#undef PG8_STAGE
#undef PG8_STAGE1
#undef PG8_LDA
#undef PG8_LDB
#undef PG8_MMA
#undef PG8_MMA_Z
#undef PG8_MMA2
#undef PG8_WAIT_V
#undef PG8_WAIT_V8E
#undef PG8_WAIT_L
#undef PG8_BAR
#undef PG8_SCHED
}

#define EPI_ROWS_BEGIN  _Pragma("unroll") for (int ai = 0; ai < 2; ++ai) _Pragma("unroll") for (int m = 0; m < 4; ++m) { const int row = u.pm * BM + ai * HALF + wr * 64 + m * 16 + fr;
#define EPI_ROWS_END    if (m & 1) asm volatile("" ::: "memory"); }
#define EPI_ROWS_END4   if (m == 3) asm volatile("" ::: "memory"); }
#define EPI_COL(bj) ((bj) * HALF + wc * 32 + fq * 8)

struct EpiProj {
    static constexpr int NSE = 0;
    static constexpr int MIDT = 0;
    const float* rinv1; unsigned char* LQ8; bf16_t* LAT; float* SSQ; bf16_t* Qb; bf16_t* Kb; bf16_t* Vb; unsigned char* GATES; const float* b_gate; const float* gk; const LAS float* T16;
    __device__ __forceinline__ void operator()(const f32x4 (&acc)[2][2][4][2], const Unit& u, int wr, int wc, int fr, int fq) const {
        const int pn = u.pn;
        float riv[2][4];
#pragma unroll
        for (int ai = 0; ai < 2; ++ai)
#pragma unroll
            for (int m = 0; m < 4; ++m) riv[ai][m] = rinv1[u.pm * BM + ai * HALF + wr * 64 + m * 16 + fr];
        if (pn >= 8) {
            f32x4 bv[2][2];
#pragma unroll
            for (int bj = 0; bj < 2; ++bj) { const int gc = (pn - 8) * BM + EPI_COL(bj); bv[bj][0] = *(const f32x4*)(b_gate + gc) * -1.4426950408889634f; bv[bj][1] = *(const f32x4*)(b_gate + gc + 4) * -1.4426950408889634f; }
            EPI_ROWS_BEGIN
                const float ri = riv[ai][m] * (0.03125f * -1.4426950408889634f);
#pragma unroll
                for (int bj = 0; bj < 2; ++bj) { const int gc = (pn - 8) * BM + EPI_COL(bj);
                    f32x4 v0 = acc[ai][bj][m][0] * ri + bv[bj][0], v1 = acc[ai][bj][m][1] * ri + bv[bj][1];
#pragma unroll
                    for (int j = 0; j < 4; ++j) { v0[j] = __builtin_amdgcn_rcpf(fmaf(__builtin_amdgcn_exp2f(v0[j]), 0.00390625f, 0.00390625f)); v1[j] = __builtin_amdgcn_rcpf(fmaf(__builtin_amdgcn_exp2f(v1[j]), 0.00390625f, 0.00390625f)); }
                    *(u32x2*)(GATES + (size_t)row * 2048 + gc) = pack8_fp8(v0, v1); }
            EPI_ROWS_END
        } else if (pn < 3) {
            EPI_ROWS_BEGIN
                const float ri = riv[ai][m] * 0.03125f; float ss = 0.f;
#pragma unroll
                for (int bj = 0; bj < 2; ++bj) { const f32x4 v0 = acc[ai][bj][m][0] * ri, v1 = acc[ai][bj][m][1] * ri;
                    ss += (v0[0] * v0[0] + v0[1] * v0[1]) + (v0[2] * v0[2] + v0[3] * v0[3]) + (v1[0] * v1[0] + v1[1] * v1[1]) + (v1[2] * v1[2] + v1[3] * v1[3]);
                    *(u32x2*)(LQ8 + (size_t)row * QL + pn * BM + EPI_COL(bj)) = pack8_fp8(v0 * 16.f, v1 * 16.f); }
                ss += __shfl_xor(ss, 16); ss += __shfl_xor(ss, 32);
                if (fq == 0) SSQ[(size_t)row * 16 + pn * 4 + wc] = ss;
            EPI_ROWS_END
        } else if (pn < 4) {
            EPI_ROWS_BEGIN
                const float ri = riv[ai][m] * 0.03125f; float ss = 0.f;
#pragma unroll
                for (int bj = 0; bj < 2; ++bj) { const f32x4 v0 = acc[ai][bj][m][0] * ri, v1 = acc[ai][bj][m][1] * ri;
                    ss += (v0[0] * v0[0] + v0[1] * v0[1]) + (v0[2] * v0[2] + v0[3] * v0[3]) + (v1[0] * v1[0] + v1[1] * v1[1]) + (v1[2] * v1[2] + v1[3] * v1[3]);
                    *(u32x4*)(LAT + (size_t)row * LATW + pn * BM + EPI_COL(bj)) = pack8(v0, v1); }
                ss += __shfl_xor(ss, 16); ss += __shfl_xor(ss, 32);
                if (fq == 0) SSQ[(size_t)row * 16 + pn * 4 + wc] = ss;
            EPI_ROWS_END
        } else if (pn == 4) {
            if (wc == 0) {
                EPI_ROWS_BEGIN
                    const float ri = riv[ai][m] * 0.03125f;
                    *(u32x4*)(LAT + (size_t)row * LATW + 1024 + fq * 8) = pack8(acc[ai][0][m][0] * ri, acc[ai][0][m][1] * ri);
                EPI_ROWS_END
            }
        } else if (pn < 7) {
            EPI_ROWS_BEGIN
                const float ri = riv[ai][m] * 0.03125f; const int b = row >> 12, s = row & 4095;
#pragma unroll
                for (int bj = 0; bj < 2; ++bj) { const int col = EPI_COL(bj), head = (pn - 5) * 4 + (col >> 6), d = col & 63;
                    *(u32x4*)(Qb + ((size_t)(b * 8 + head) * SEQ + s) * 64 + d) = pack8(acc[ai][bj][m][0] * ri, acc[ai][bj][m][1] * ri); }
            EPI_ROWS_END
        } else {
            if (wc < 2) {
                const f32x4 g00 = *(const f32x4*)(gk + 8 * fq), g01 = *(const f32x4*)(gk + 8 * fq + 4), g10 = *(const f32x4*)(gk + 32 + 8 * fq), g11 = *(const f32x4*)(gk + 32 + 8 * fq + 4);
                EPI_ROWS_BEGIN
                    const float ri = riv[ai][m] * 0.03125f; const int b = row >> 12, s = row & 4095;
                    f32x4 a0 = acc[ai][0][m][0] * ri, a1 = acc[ai][0][m][1] * ri, c0 = acc[ai][1][m][0] * ri, c1 = acc[ai][1][m][1] * ri;
                    float ss = ((a0[0] * a0[0] + a0[1] * a0[1]) + (a0[2] * a0[2] + a0[3] * a0[3])) + ((a1[0] * a1[0] + a1[1] * a1[1]) + (a1[2] * a1[2] + a1[3] * a1[3]))
                             + ((c0[0] * c0[0] + c0[1] * c0[1]) + (c0[2] * c0[2] + c0[3] * c0[3])) + ((c1[0] * c1[0] + c1[1] * c1[1]) + (c1[2] * c1[2] + c1[3] * c1[3]));
                    ss += __shfl_xor(ss, 16); ss += __shfl_xor(ss, 32);
                    const float rn = 1.0f / sqrtf(ss * (1.0f / 64.f) + EPS);
                    a0 = a0 * rn * g00; a1 = a1 * rn * g01; c0 = c0 * rn * g10; c1 = c1 * rn * g11;
                    const LAS float* tr = T16 + ((s >> 6) * 16 + 4 * fq) * 2; const LAS float* tc = T16 + ((s & 63) * 16 + 4 * fq) * 2;
                    a0 = rope4t(a0, *(const LAS f32x4*)tr); a1 = rope4t(a1, *(const LAS f32x4*)(tr + 4)); c0 = rope4t(c0, *(const LAS f32x4*)tc); c1 = rope4t(c1, *(const LAS f32x4*)(tc + 4));
                    unsigned char* kp = (unsigned char*)Kb + ((size_t)(b * 2 + wc) * SEQ + s) * 64 + 8 * fq;
                    *(u32x2*)kp = pack8_fp8(a0, a1); *(u32x2*)(kp + 32) = pack8_fp8(c0, c1);
                    asm volatile("" ::: "memory");
                EPI_ROWS_END
            } else {
                EPI_ROWS_BEGIN
                    const float ri = riv[ai][m] * 0.03125f; const int b = row >> 12, s = row & 4095;
                    store_vt(Vb + (size_t)(b * 2 + (wc - 2)) * 64 * SEQ, 8 * fq, s, acc[ai][0][m][0] * ri, acc[ai][0][m][1] * ri, acc[ai][1][m][0] * ri, acc[ai][1][m][1] * ri);
                EPI_ROWS_END
            }
        }
    }
};
struct EpiQup {
    static constexpr int NSE = 16;
    static constexpr int MIDT = 0;
    const float* SSQ; bf16_t* Qa;
    __device__ __forceinline__ void operator()(const f32x4 (&acc)[2][2][4][2], const Unit& u, int wr, int wc, int fr, int fq) const {
        float riq[2][4];
#pragma unroll
        for (int ai = 0; ai < 2; ++ai)
#pragma unroll
            for (int m = 0; m < 4; ++m) { const f32x4* sp = (const f32x4*)(SSQ + (size_t)(u.pm * BM + ai * HALF + wr * 64 + m * 16 + fr) * 16); const f32x4 s0 = sp[0], s1 = sp[1], s2 = sp[2];
                const float ss = ((s0[0] + s0[1]) + (s0[2] + s0[3])) + ((s1[0] + s1[1]) + (s1[2] + s1[3])) + ((s2[0] + s2[1]) + (s2[2] + s2[3]));
                riq[ai][m] = (1.0f / 512.f) / sqrtf(ss * (1.0f / QL) + EPS); }
        asm volatile("" ::: "memory");
        EPI_ROWS_BEGIN
            const float ri = riq[ai][m]; const int b = row >> 12, s = row & 4095;
#pragma unroll
            for (int bj = 0; bj < 2; ++bj) { const int cg_ = u.pn * BM + EPI_COL(bj), h = cg_ / 96, d = cg_ - h * 96;
                *(u32x4*)(Qa + ((size_t)(b * 8 + h) * SEQ + s) * 96 + d) = pack8(acc[ai][bj][m][0] * ri, acc[ai][bj][m][1] * ri); }
        EPI_ROWS_END
    }
};
struct EpiKVup {
    static constexpr int NSE = 24;
    static constexpr int MIDT = 0;
    const float* SSQ; const bf16_t* LAT; const float* gk; const LAS float* T8; bf16_t* Ka; bf16_t* Va;
    __device__ __forceinline__ void operator()(const f32x4 (&acc)[2][2][4][2], const Unit& u, int wr, int wc, int fr, int fq) const {
        const int h = u.pn * 2 + (wc >> 1);
        float rik[2][4];
#pragma unroll
        for (int ai = 0; ai < 2; ++ai)
#pragma unroll
            for (int m = 0; m < 4; ++m) { const f32x4 s3 = *(const f32x4*)(SSQ + (size_t)(u.pm * BM + ai * HALF + wr * 64 + m * 16 + fr) * 16 + 12); rik[ai][m] = 1.0f / sqrtf(((s3[0] + s3[1]) + (s3[2] + s3[3])) * (1.0f / KVL) + EPS); }
        if (wc & 1) {
            EPI_ROWS_BEGIN
                const float ri = rik[ai][m]; const int b = row >> 12, s = row & 4095;
                store_vt(Va + (size_t)(b * 8 + h) * 64 * SEQ, 8 * fq, s, acc[ai][0][m][0] * ri, acc[ai][0][m][1] * ri, acc[ai][1][m][0] * ri, acc[ai][1][m][1] * ri);
            EPI_ROWS_END
        } else {
            const f32x4 g00 = *(const f32x4*)(gk + 8 * fq), g01 = *(const f32x4*)(gk + 8 * fq + 4), g10 = *(const f32x4*)(gk + 32 + 8 * fq), g11 = *(const f32x4*)(gk + 32 + 8 * fq + 4);
            const f32x4 gr0 = *(const f32x4*)(gk + 64 + 8 * fq), gr1 = *(const f32x4*)(gk + 64 + 8 * fq + 4);
            u32x4 krv[2][4];
#pragma unroll
            for (int ai = 0; ai < 2; ++ai)
#pragma unroll
                for (int m = 0; m < 4; ++m) krv[ai][m] = *(const u32x4*)(LAT + (size_t)(u.pm * BM + ai * HALF + wr * 64 + m * 16 + fr) * LATW + 1024 + 8 * fq);
            asm volatile("" ::: "memory");
            EPI_ROWS_BEGIN
                const float ri = rik[ai][m]; const int b = row >> 12, s = row & 4095;
                f32x4 a0 = acc[ai][0][m][0] * ri, a1 = acc[ai][0][m][1] * ri, c0 = acc[ai][1][m][0] * ri, c1 = acc[ai][1][m][1] * ri, r0, r1;
                unpack8(krv[ai][m], r0, r1);
                float ss = ((a0[0] * a0[0] + a0[1] * a0[1]) + (a0[2] * a0[2] + a0[3] * a0[3])) + ((a1[0] * a1[0] + a1[1] * a1[1]) + (a1[2] * a1[2] + a1[3] * a1[3]))
                         + ((c0[0] * c0[0] + c0[1] * c0[1]) + (c0[2] * c0[2] + c0[3] * c0[3])) + ((c1[0] * c1[0] + c1[1] * c1[1]) + (c1[2] * c1[2] + c1[3] * c1[3]))
                         + ((r0[0] * r0[0] + r0[1] * r0[1]) + (r0[2] * r0[2] + r0[3] * r0[3])) + ((r1[0] * r1[0] + r1[1] * r1[1]) + (r1[2] * r1[2] + r1[3] * r1[3]));
                ss += __shfl_xor(ss, 16); ss += __shfl_xor(ss, 32);
                const float rn = 1.0f / sqrtf(ss * (1.0f / 96.f) + EPS);
                r0 = r0 * rn * gr0; r1 = r1 * rn * gr1;
                const LAS float* tp = T8 + (((fq < 2) ? (s >> 6) : (s & 63)) * 8 + ((4 * fq) & 7)) * 2;
                r0 = rope4t(r0, *(const LAS f32x4*)tp); r1 = rope4t(r1, *(const LAS f32x4*)(tp + 4));
                unsigned char* kp = (unsigned char*)Ka + ((size_t)(b * 8 + h) * SEQ + s) * 96 + 8 * fq;
                *(u32x2*)kp = pack8_fp8(a0 * rn * g00, a1 * rn * g01); *(u32x2*)(kp + 32) = pack8_fp8(c0 * rn * g10, c1 * rn * g11); *(u32x2*)(kp + 64) = pack8_fp8(r0, r1);
                asm volatile("" ::: "memory");
            EPI_ROWS_END
        }
    }
};
struct EpiMerge2 {
    static constexpr int NSE = 16;
    static constexpr int MIDT = 4;
    const unsigned char* GATES; unsigned char* MG;
    __device__ __forceinline__ void mid(f32x4 (&acc)[2][2][4][2], const Unit& u, int wr, int wc, int fr, int fq) const {
        EPI_ROWS_BEGIN
#pragma unroll
            for (int bj = 0; bj < 2; ++bj) { const int c = u.pn * BM + EPI_COL(bj);
                f32x4 a0, a1, b0, b1; unpack8_fp8(*(const u32x2*)(GATES + (size_t)row * 2048 + c), a0, a1); unpack8_fp8(*(const u32x2*)(GATES + (size_t)row * 2048 + 1024 + c), b0, b1);
#pragma unroll
                for (int j = 0; j < 4; ++j) { acc[ai][bj][m][0][j] *= a0[j] * __builtin_amdgcn_rcpf(fmaxf(b0[j], 1e-30f)); acc[ai][bj][m][1][j] *= a1[j] * __builtin_amdgcn_rcpf(fmaxf(b1[j], 1e-30f)); } }
        EPI_ROWS_END4
    }
    __device__ __forceinline__ void operator()(const f32x4 (&acc)[2][2][4][2], const Unit& u, int wr, int wc, int fr, int fq) const {
        EPI_ROWS_BEGIN
#pragma unroll
            for (int bj = 0; bj < 2; ++bj) { const int c = u.pn * BM + EPI_COL(bj);
                f32x4 b0, b1; unpack8_fp8(*(const u32x2*)(GATES + (size_t)row * 2048 + 1024 + c), b0, b1);
                *(u32x2*)(MG + (size_t)row * DM + c) = pack8_fp8(acc[ai][bj][m][0] * b0 * 0.0001220703125f, acc[ai][bj][m][1] * b1 * 0.0001220703125f); }
        EPI_ROWS_END4
    }
};
struct EpiOut {
    static constexpr int NSE = 32;
    static constexpr int MIDT = 0;
    const bf16_t* x; bf16_t* x1h; unsigned char* x1f8;
    __device__ __forceinline__ void operator()(const f32x4 (&acc)[2][2][4][2], const Unit& u, int wr, int wc, int fr, int fq) const {
        u32x4 xv[2][4][2];
#pragma unroll
        for (int ai = 0; ai < 2; ++ai)
#pragma unroll
            for (int m = 0; m < 4; ++m) { const int row = u.pm * BM + ai * HALF + wr * 64 + m * 16 + fr;
#pragma unroll
                for (int bj = 0; bj < 2; ++bj) xv[ai][m][bj] = __builtin_nontemporal_load((const u32x4*)(x + (size_t)row * DM + u.pn * BM + EPI_COL(bj))); }
        asm volatile("" ::: "memory");
#pragma unroll
        for (int ai = 0; ai < 2; ++ai)
#pragma unroll
            for (int m = 0; m < 4; ++m) { const int row = u.pm * BM + ai * HALF + wr * 64 + m * 16 + fr;
#pragma unroll
                for (int bj = 0; bj < 2; ++bj) { const size_t o = (size_t)row * DM + u.pn * BM + EPI_COL(bj);
                    f32x4 x0, x1_; unpack8_f16(xv[ai][m][bj], x0, x1_); const f32x4 v0 = acc[ai][bj][m][0] * 0.00048828125f + x0, v1 = acc[ai][bj][m][1] * 0.00048828125f + x1_;
                    *(u32x4*)(x1h + o) = pack8_f16(v0, v1); *(u32x2*)(x1f8 + o) = pack8_fp8(v0, v1); } }
    }
};
struct EpiSwiGLU {
    static constexpr int NSE = 8;
    static constexpr int MIDT = 0;
    const float* RG; unsigned char* ACT;
    __device__ __forceinline__ void operator()(const f32x4 (&acc)[2][2][4][2], const Unit& u, int wr, int wc, int fr, int fq) const {
        float rg_[2][4];
#pragma unroll
        for (int ai = 0; ai < 2; ++ai)
#pragma unroll
            for (int m = 0; m < 4; ++m) rg_[ai][m] = RG[u.pm * BM + ai * HALF + wr * 64 + m * 16 + fr];
        EPI_ROWS_BEGIN
            const float ri = rg_[ai][m] * 0.015625f;
            const float nl = ri * -1.4426950408889634f, r4 = 4.f * ri * ri;
            f32x4 a0, a1;
#pragma unroll
            for (int j = 0; j < 4; ++j) {
                a0[j] = (acc[ai][0][m][0][j] * acc[ai][1][m][0][j]) * r4 * __builtin_amdgcn_rcpf(1.f + __builtin_amdgcn_exp2f(acc[ai][0][m][0][j] * nl));
                a1[j] = (acc[ai][0][m][1][j] * acc[ai][1][m][1][j]) * r4 * __builtin_amdgcn_rcpf(1.f + __builtin_amdgcn_exp2f(acc[ai][0][m][1][j] * nl)); }
            *(u32x2*)(ACT + (size_t)row * FF + u.pn * HALF + wc * 32 + fq * 8) = pack8_fp8(a0, a1);
        EPI_ROWS_END
    }
};
struct EpiDown {
    static constexpr int NSE = 16;
    static constexpr int MIDT = 0;
    const float* GATEV; unsigned char* YE;
    __device__ __forceinline__ void operator()(const f32x4 (&acc)[2][2][4][2], const Unit& u, int wr, int wc, int fr, int fq) const {
        float gv_[2][4];
#pragma unroll
        for (int ai = 0; ai < 2; ++ai)
#pragma unroll
            for (int m = 0; m < 4; ++m) gv_[ai][m] = GATEV[u.pm * BM + ai * HALF + wr * 64 + m * 16 + fr];
        EPI_ROWS_BEGIN
            const float gv = gv_[ai][m] * 0.25f;
#pragma unroll
            for (int bj = 0; bj < 2; ++bj) *(u32x2*)(YE + (size_t)row * DM + u.pn * BM + EPI_COL(bj)) = pack8_fp8(acc[ai][bj][m][0] * gv, acc[ai][bj][m][1] * gv);
        EPI_ROWS_END
    }
};
}

namespace att {
using bf16 = __hip_bfloat16;
constexpr int NW = 8, QBLK = 32, KVBLK = 64, DV = 64;
constexpr float THR = 8.f;
#define SBAR() __builtin_amdgcn_sched_barrier(0)
__device__ __forceinline__ int crow(int r, int hi) { return (r & 3) + 8 * (r >> 2) + 4 * hi; }
__device__ __forceinline__ unsigned cvtpk(float lo, float hi) { unsigned r; asm volatile("v_cvt_pk_bf16_f32 %0, %1, %2" : "=v"(r) : "v"(lo), "v"(hi)); return r; }

template <int DQK> struct Cfg4 {
    static constexpr int NK = (DQK + 63) / 64;
    static constexpr int KSTR = (DQK == 64) ? 80 : 144;
    static constexpr int VSTR = 144;
    static constexpr int KT = KVBLK * KSTR, VT = DV * VSTR;
    static constexpr int OFF_K = 0, OFF_V = 2 * KT, OFF_WS = OFF_V + 3 * VT, OFF_OST = OFF_WS + NW * 64 * 4, BYTES = OFF_OST + NW * 4096;
    static constexpr int NPK = KVBLK * DQK / 16;
};
typedef int v8i_t __attribute__((ext_vector_type(8)));
typedef int v4i_t __attribute__((ext_vector_type(4)));

template <int DQK>
__device__ __forceinline__ void load_q8(v8i_t (&qf)[Cfg4<DQK>::NK], const bf16_t* Qrow, const float* __restrict__ g, const float* __restrict__ TB, int spos, int hi) {
    constexpr int NK = Cfg4<DQK>::NK; constexpr float CS8 = ((DQK == 96) ? 0.14724444f : 0.18033688f) * 8.f;
    f32x4 v[NK][8]; float ss = 0.f;
#pragma unroll
    for (int j = 0; j < NK; ++j) { const bool valid = (DQK == 64) || (j == 0) || (hi == 0);
#pragma unroll
        for (int q = 0; q < 4; ++q) { u32x4 w = {0u, 0u, 0u, 0u}; if (valid) w = *reinterpret_cast<const u32x4*>(Qrow + 64 * j + 32 * hi + 8 * q); unpack8(w, v[j][2 * q], v[j][2 * q + 1]); }
#pragma unroll
        for (int q = 0; q < 8; ++q) ss += (v[j][q][0] * v[j][q][0] + v[j][q][1] * v[j][q][1]) + (v[j][q][2] * v[j][q][2] + v[j][q][3] * v[j][q][3]); }
    ss += __shfl_xor(ss, 32);
    const float rn = CS8 / sqrtf(ss * (1.0f / DQK) + EPS);
    const int prow = spos >> 6, pcol = spos & 63;
#pragma unroll
    for (int j = 0; j < NK; ++j) { const bool valid = (DQK == 64) || (j == 0) || (hi == 0); const int d0 = valid ? 64 * j + 32 * hi : 0;
#pragma unroll
        for (int q = 0; q < 8; ++q) { v[j][q] = v[j][q] * rn * *(const f32x4*)(g + d0 + 4 * q);
            if (DQK == 64) v[j][q] = rope4t(v[j][q], *(const f32x4*)(TB + ((hi ? pcol : prow) * 16 + 2 * q) * 2));
            else if (j == 1) v[j][q] = rope4t(v[j][q], *(const f32x4*)(TB + (((q < 4) ? prow : pcol) * 8 + 2 * (q & 3)) * 2)); }
        u32x2 w0 = pack8_fp8(v[j][0], v[j][1]), w1 = pack8_fp8(v[j][2], v[j][3]), w2 = pack8_fp8(v[j][4], v[j][5]), w3 = pack8_fp8(v[j][6], v[j][7]);
        if (!valid) { w0 = (u32x2){0u, 0u}; w1 = w0; w2 = w0; w3 = w0; }
        qf[j] = (v8i_t){(int)w0.x, (int)w0.y, (int)w1.x, (int)w1.y, (int)w2.x, (int)w2.y, (int)w3.x, (int)w3.y}; }
}

template <int DQK, bool SHIFT>
__device__ __forceinline__ void attn_step4(f32x16& C0, f32x16& C1, f32x16& N0, f32x16& N1, bf16x8& W0, bf16x8& W1, bf16x8& W2, bf16x8& W3,
                                           const bf16x8& R0, const bf16x8& R1, const bf16x8& R2, const bf16x8& R3, f32x16 (&o)[2], float& l0, float& l1, float& l2, float& l3,
                                           const v8i_t (&qf)[Cfg4<DQK>::NK], const LAS char* kp, const LAS char* vp, int sc_k, int sc_q, float nsh) {
    constexpr int KSTR = Cfg4<DQK>::KSTR, NK = Cfg4<DQK>::NK, NQ = 2 * NK, NS = NQ + 8;
    v8i_t kq[NQ]; bf16x8 vfr_[8];
#define SLOT_ISQ(s) ((DQK == 64) ? ((s) == 0 || (s) == 5) : (((s) % 3) == 0))
#define SLOT_IDX(s) ((DQK == 64) ? (SLOT_ISQ(s) ? ((s) == 5) : ((s) < 5 ? (s) - 1 : (s) - 2)) : (SLOT_ISQ(s) ? (s) / 3 : (s) - (s) / 3 - 1))
#define FRAG_RD(s) do { if ((s) < NS) { if (SLOT_ISQ(s)) { const int i_ = SLOT_IDX(s); const LAS char* p_ = kp + (i_ & 1) * 32 * KSTR + (i_ >> 1) * 64; \
            kq[i_] = __builtin_shufflevector(*(const LAS v4i_t*)p_, *(const LAS v4i_t*)(p_ + 16), 0, 1, 2, 3, 4, 5, 6, 7); } \
        else { const int j_ = SLOT_IDX(s); vfr_[j_] = *(const LAS bf16x8*)(vp + (j_ & 1) * 32 * Cfg4<DQK>::VSTR + (j_ >> 1) * 32); } } } while (0)
#define EXPQ(P, B) do { if (SHIFT) { P[B] += nsh; P[B + 1] += nsh; P[B + 2] += nsh; P[B + 3] += nsh; } \
        P[B] = __builtin_amdgcn_exp2f(P[B]); P[B + 1] = __builtin_amdgcn_exp2f(P[B + 1]); P[B + 2] = __builtin_amdgcn_exp2f(P[B + 2]); P[B + 3] = __builtin_amdgcn_exp2f(P[B + 3]); } while (0)
#define ADDQ(P, B) do { l0 += P[B]; l1 += P[B + 1]; l2 += P[B + 2]; l3 += P[B + 3]; } while (0)
#define PKN(P, BASE, OUT) do { u32x4 w_ = {cvtpk(P[BASE + 0], P[BASE + 1]), cvtpk(P[BASE + 2], P[BASE + 3]), cvtpk(P[BASE + 4], P[BASE + 5]), cvtpk(P[BASE + 6], P[BASE + 7])}; OUT = __builtin_bit_cast(bf16x8, w_); } while (0)
#define CHUNK(g) do { \
        if ((g) == 0) { EXPQ(C0, 4); ADDQ(C0, 0); } else if ((g) == 1) { EXPQ(C0, 8); ADDQ(C0, 4); } else if ((g) == 2) { PKN(C0, 0, W0); EXPQ(C0, 12); } \
        else if ((g) == 3) { ADDQ(C0, 8); EXPQ(C1, 0); } else if ((g) == 4) { ADDQ(C0, 12); PKN(C0, 8, W1); } else if ((g) == 5) { EXPQ(C1, 4); ADDQ(C1, 0); } \
        else if ((g) == 6) { EXPQ(C1, 8); ADDQ(C1, 4); } else if ((g) == 7) { PKN(C1, 0, W2); EXPQ(C1, 12); } else if ((g) == 8) { ADDQ(C1, 8); ADDQ(C1, 12); } \
        else if ((g) == 9) { PKN(C1, 8, W3); } } while (0)
    FRAG_RD(0); FRAG_RD(1);
    EXPQ(C0, 0);
    __builtin_amdgcn_sched_barrier(0);
#pragma unroll
    for (int s = 0; s < NS; ++s) {
        if (SLOT_ISQ(s)) { const int i = SLOT_IDX(s);
            if ((i >> 1) == 0) { if (i & 1) asm volatile("v_mfma_scale_f32_32x32x64_f8f6f4 %0, %1, %2, 0, %3, %4 op_sel_hi:[0,0,0]" : "=&v"(N1) : "v"(kq[i]), "v"(qf[0]), "v"(sc_k), "v"(sc_q));
                                 else       asm volatile("v_mfma_scale_f32_32x32x64_f8f6f4 %0, %1, %2, 0, %3, %4 op_sel_hi:[0,0,0]" : "=&v"(N0) : "v"(kq[i]), "v"(qf[0]), "v"(sc_k), "v"(sc_q)); }
            else               { if (i & 1) asm volatile("v_mfma_scale_f32_32x32x64_f8f6f4 %0, %1, %2, %0, %3, %4 op_sel_hi:[0,0,0]" : "+v"(N1) : "v"(kq[i]), "v"(qf[NK - 1]), "v"(sc_k), "v"(sc_q));
                                 else       asm volatile("v_mfma_scale_f32_32x32x64_f8f6f4 %0, %1, %2, %0, %3, %4 op_sel_hi:[0,0,0]" : "+v"(N0) : "v"(kq[i]), "v"(qf[NK - 1]), "v"(sc_k), "v"(sc_q)); }
        } else { const int j = SLOT_IDX(s);
            const bf16x8 pa = ((j >> 1) == 0) ? R0 : ((j >> 1) == 1) ? R1 : ((j >> 1) == 2) ? R2 : R3;
            o[j & 1] = __builtin_amdgcn_mfma_f32_32x32x16_bf16(pa, vfr_[j], o[j & 1], 0, 0, 0); }
        FRAG_RD(s + 2);
        CHUNK(s);
        __builtin_amdgcn_sched_barrier(0);
    }
#undef SLOT_ISQ
#undef SLOT_IDX
#undef FRAG_RD
#undef EXPQ
#undef ADDQ
#undef PKN
#undef CHUNK
}

template <int DQK, int LDO, bool SHIFT>
__device__ __forceinline__ void attn_unit4(const bf16_t* __restrict__ Qb, const unsigned char* __restrict__ Kh, const bf16_t* __restrict__ Vh, unsigned char* __restrict__ Ob, int seq, LAS char* lds, float negMref, const float* gq, const float* TB, int q0) {
    using C = Cfg4<DQK>; constexpr int NK = C::NK;
    int tid = threadIdx.x; asm volatile("" : "+v"(tid));
    const int wid = tid >> 6, lane = tid & 63, r32 = lane & 31, hi = lane >> 5;
    LAS char* K_lds = lds + C::OFF_K; LAS char* V_lds = lds + C::OFF_V;
    f32x16 o[2] = {}; v8i_t qf[NK]; float l0 = 0.f, l1 = 0.f, l2 = 0.f, l3 = 0.f;
    const int sc_k = 0x7f7f7f7f, sc_q = 0x7c7c7c7c;
    constexpr int CPR = DQK / 16;
    const bool kact = tid < C::NPK; const int kr = tid / CPR, kc = tid - kr * CPR, kst0 = kr * C::KSTR + kc * 16;
    const int sr = tid >> 3, sc = (tid & 7) * 8, vst0 = sr * C::VSTR + sc * 2;
    if (DQK == 96) {
        if (tid < 256) { const int slot = tid >> 7, r_ = (tid >> 1) & 63, c_ = tid & 1; *(LAS u32x4*)(K_lds + slot * C::KT + r_ * C::KSTR + 96 + 16 * c_) = (u32x4){0u, 0u, 0u, 0u}; } }
    const LAS char* kfr = K_lds + r32 * C::KSTR + hi * 32;
    const LAS char* vfr = V_lds + r32 * C::VSTR + hi * 16;
    u32x4 ks0 = {0u, 0u, 0u, 0u}; bf16x8 vs;
#define LOADK(t) do { if (kact) ks0 = *reinterpret_cast<const u32x4*>(Kh + (long)(t) * KVBLK * DQK + tid * 16); } while (0)
#define LOADV(t) do { vs = *reinterpret_cast<const bf16x8*>(&Vh[(long)sr * seq + (t) * KVBLK + sc]); } while (0)
#define WRITEK(slotoff) do { if (kact) *(LAS u32x4*)(K_lds + (slotoff) + kst0) = ks0; } while (0)
#define WRITEV(slotoff) do { *(LAS bf16x8*)(V_lds + (slotoff) + vst0) = vs; } while (0)
    const int NT = seq / KVBLK;
    {
        u32x4 kp1 = {0u, 0u, 0u, 0u};
        LOADK(0); if (kact) kp1 = *reinterpret_cast<const u32x4*>(Kh + (long)KVBLK * DQK + tid * 16); LOADV(0);
        load_q8<DQK>(qf, Qb + (long)(wid * QBLK + r32) * DQK, gq, TB, q0 + wid * QBLK + r32, hi);
        WRITEK(0); WRITEV(0); if (kact) *(LAS u32x4*)(K_lds + C::KT + kst0) = kp1;
        LOADK(2); LOADV(1);
    }
    __syncthreads();
    f32x16 pA0, pA1, pB0, pB1; bf16x8 xa0 = {}, xa1 = {}, xa2 = {}, xa3 = {}, ya0 = {}, ya1 = {}, ya2 = {}, ya3 = {};
    {
#pragma unroll
        for (int j = 0; j < NK; ++j) {
            const LAS char* p0_ = kfr + j * 64; const LAS char* p1_ = p0_ + 32 * C::KSTR;
            const v8i_t k0_ = __builtin_shufflevector(*(const LAS v4i_t*)p0_, *(const LAS v4i_t*)(p0_ + 16), 0, 1, 2, 3, 4, 5, 6, 7);
            const v8i_t k1_ = __builtin_shufflevector(*(const LAS v4i_t*)p1_, *(const LAS v4i_t*)(p1_ + 16), 0, 1, 2, 3, 4, 5, 6, 7);
            if (j == 0) { asm volatile("v_mfma_scale_f32_32x32x64_f8f6f4 %0, %1, %2, 0, %3, %4 op_sel_hi:[0,0,0]" : "=&v"(pA0) : "v"(k0_), "v"(qf[0]), "v"(sc_k), "v"(sc_q));
                          asm volatile("v_mfma_scale_f32_32x32x64_f8f6f4 %0, %1, %2, 0, %3, %4 op_sel_hi:[0,0,0]" : "=&v"(pA1) : "v"(k1_), "v"(qf[0]), "v"(sc_k), "v"(sc_q)); }
            else        { asm volatile("v_mfma_scale_f32_32x32x64_f8f6f4 %0, %1, %2, %0, %3, %4 op_sel_hi:[0,0,0]" : "+v"(pA0) : "v"(k0_), "v"(qf[NK - 1]), "v"(sc_k), "v"(sc_q));
                          asm volatile("v_mfma_scale_f32_32x32x64_f8f6f4 %0, %1, %2, %0, %3, %4 op_sel_hi:[0,0,0]" : "+v"(pA1) : "v"(k1_), "v"(qf[NK - 1]), "v"(sc_k), "v"(sc_q)); } }
        asm volatile("s_nop 15\n\ts_nop 15" ::: "memory");
    }
#define VFRAG(L, H) (bf16x8){L[0], L[1], L[2], L[3], H[0], H[1], H[2], H[3]}
#define STEP(C0, C1, N0, N1, W0, W1, W2, W3, R0, R1, R2, R3, koff, voff) attn_step4<DQK, SHIFT>(C0, C1, N0, N1, W0, W1, W2, W3, R0, R1, R2, R3, o, l0, l1, l2, l3, qf, kfr + (koff), vfr + (voff), sc_k, sc_q, negMref)
    int kcur = C::KT, vprev = 0, vnext = C::VT;
    for (int t = 0; t < NT; t += 2) {
        __syncthreads();
        WRITEK(C::KT - kcur); WRITEV(vnext);
        { const int tk = (t + 3 < NT) ? t + 3 : NT - 1, tv = (t + 2 < NT) ? t + 2 : NT - 1; LOADK(tk); LOADV(tv); }
        STEP(pA0, pA1, pB0, pB1, xa0, xa1, xa2, xa3, ya0, ya1, ya2, ya3, kcur, vprev);
        vprev = (t == 0) ? 0 : (vprev == 2 * C::VT ? 0 : vprev + C::VT); vnext = (vnext == 2 * C::VT) ? 0 : vnext + C::VT; kcur = C::KT - kcur;
        __syncthreads();
        WRITEK(C::KT - kcur); WRITEV(vnext);
        { const int tk = (t + 4 < NT) ? t + 4 : NT - 1, tv = (t + 3 < NT) ? t + 3 : NT - 1; LOADK(tk); LOADV(tv); }
        STEP(pB0, pB1, pA0, pA1, ya0, ya1, ya2, ya3, xa0, xa1, xa2, xa3, kcur, vprev);
        vprev = (vprev == 2 * C::VT) ? 0 : vprev + C::VT; vnext = (vnext == 2 * C::VT) ? 0 : vnext + C::VT; kcur = C::KT - kcur;
    }
    {   const LAS char* vp_ = vfr + vprev;
#pragma unroll
        for (int d0 = 0; d0 < 2; ++d0) {
            const bf16x8 f0 = *(const LAS bf16x8*)(vp_ + d0 * 32 * C::VSTR), f1 = *(const LAS bf16x8*)(vp_ + d0 * 32 * C::VSTR + 32), f2 = *(const LAS bf16x8*)(vp_ + d0 * 32 * C::VSTR + 64), f3 = *(const LAS bf16x8*)(vp_ + d0 * 32 * C::VSTR + 96);
            o[d0] = __builtin_amdgcn_mfma_f32_32x32x16_bf16(ya0, f0, o[d0], 0, 0, 0); o[d0] = __builtin_amdgcn_mfma_f32_32x32x16_bf16(ya1, f1, o[d0], 0, 0, 0);
            o[d0] = __builtin_amdgcn_mfma_f32_32x32x16_bf16(ya2, f2, o[d0], 0, 0, 0); o[d0] = __builtin_amdgcn_mfma_f32_32x32x16_bf16(ya3, f3, o[d0], 0, 0, 0); }
    }
    float l_reg = (l0 + l1) + (l2 + l3);
    { auto rr = __builtin_amdgcn_permlane32_swap(__float_as_uint(l_reg), __float_as_uint(l_reg), false, false); l_reg = __uint_as_float(rr[0]) + __uint_as_float(rr[1]); }
    LAS float* ws = (LAS float*)(lds + C::OFF_WS) + wid * 64;
    if (hi == 0) ws[r32] = l_reg;
    asm volatile("s_waitcnt lgkmcnt(0)" ::: "memory");
    float rli[16];
#pragma unroll
    for (int r = 0; r < 16; ++r) rli[r] = __builtin_amdgcn_rcpf(ws[crow(r, hi)]);
    unsigned char* Ow = Ob + (long)(wid * QBLK) * LDO;
    { LAS unsigned char* stg = (LAS unsigned char*)(lds + C::OFF_OST) + wid * 2048;
#pragma unroll
      for (int r = 0; r < 16; ++r) { const int orow = crow(r, hi); const float sc_ = rli[r] * 64.f;
          const int w_ = __builtin_amdgcn_cvt_pk_fp8_f32(o[0][r] * sc_, o[1][r] * sc_, 0, false);
          stg[orow * 64 + r32] = (unsigned char)(w_ & 0xff); stg[orow * 64 + 32 + r32] = (unsigned char)((w_ >> 8) & 0xff); }
      asm volatile("s_waitcnt lgkmcnt(0)" ::: "memory");
#pragma unroll
      for (int i = 0; i < 2; ++i) { const int row = i * 16 + (lane >> 2), ch = lane & 3; const u32x4 v = *(const LAS u32x4*)(stg + row * 64 + ch * 16); *(u32x4*)(Ow + (long)row * LDO + ch * 16) = v; } }
    asm volatile("s_waitcnt lgkmcnt(0)" ::: "memory"); __syncthreads();
#undef LOADK
#undef LOADV
#undef WRITEK
#undef WRITEV
#undef VFRAG
#undef STEP
}
#undef SBAR
}

constexpr size_t MiB = 1u << 20;
constexpr size_t WS_CTL = 0, CTL_ZERO_BYTES = 64 * 1024;
constexpr size_t WS_RINV1 = 1 * MiB, WS_RINV2 = 1 * MiB + 512 * 1024, WS_SSQ = 2 * MiB, WS_AFF = 4 * MiB, WS_IDX = 6 * MiB, WS_GATEV = 6 * MiB + 256 * 1024, WS_RG = 6 * MiB + 512 * 1024, WS_INV = 7 * MiB;
constexpr size_t WS_ROPE16 = 6 * MiB + 768 * 1024, WS_ROPE8 = WS_ROPE16 + 8192;
constexpr size_t WS_WIN = 9 * MiB, WS_WQUP = 17 * MiB, WS_WKVUP = 18 * MiB + 256 * 1024, WS_WA = 19 * MiB, WS_WB = 20 * MiB, WS_WO = 21 * MiB;
constexpr size_t WS_XB = 24 * MiB;
constexpr size_t WS_MG = 56 * MiB;
constexpr size_t WS_LAT = 88 * MiB;
constexpr size_t WS_GATES = 154 * MiB;
constexpr size_t WS_X1H = WS_GATES;
constexpr size_t WS_QB = 218 * MiB, WS_KB = 250 * MiB, WS_VB = 254 * MiB, WS_QA = 262 * MiB, WS_KA = 310 * MiB, WS_VA = 334 * MiB;
constexpr size_t WS_WGU = 366 * MiB, WS_WD = 398 * MiB;
constexpr size_t WS_ACT = 88 * MiB, WS_XE = 218 * MiB;
constexpr size_t WS_XH = 414 * MiB;
constexpr size_t WS_LQ8 = 478 * MiB;
constexpr size_t WS_END = 502 * MiB;


#define XB_TMO      128
#define XB_XCNT(j)  (256  + 64 * (j))
#define XB_XSUB(j)  (1280 + 64 * (j))
#define XB_XGEN(j)  (2304 + 64 * (j))
#define XB_TOP      3328
#define XB_TOPGEN   3392
#define XCD_BAR_WORDS 3456
#define XB_SPIN_CAP (1u << 22)
__device__ __forceinline__ unsigned xb_ld(unsigned* p)              { return __hip_atomic_load(p, __ATOMIC_RELAXED, __HIP_MEMORY_SCOPE_AGENT); }
__device__ __forceinline__ unsigned xb_add(unsigned* p, unsigned v) { return __hip_atomic_fetch_add(p, v, __ATOMIC_RELAXED, __HIP_MEMORY_SCOPE_AGENT); }
__device__ __forceinline__ unsigned xb_xcc_id() { return (unsigned)__builtin_amdgcn_s_getreg((3 << 11) | 20) & 0xFu; }
#define XB_SPIN(cond, bar) do { unsigned _sp = 0; while (cond) { __builtin_amdgcn_s_sleep(1); \
    if ((++_sp & 255u) == 0u) { if (xb_ld(&(bar)[XB_TMO])) break; if (_sp > XB_SPIN_CAP) { atomicAdd(&(bar)[XB_TMO], 1u); break; } } } } while (0)
struct XcdBarrier { unsigned* bar; unsigned x; volatile LAS unsigned* st; };
__device__ __forceinline__ XcdBarrier xcd_barrier_post(unsigned* bar, volatile LAS unsigned* st) {
    XcdBarrier b; b.bar = bar; b.x = xb_xcc_id(); b.st = st;
    if (threadIdx.x == 0) st[2] = xb_add(&bar[XB_XCNT(b.x)], 1u);
    return b;
}
__device__ __forceinline__ void xcd_barrier_complete(unsigned* bar, unsigned x, unsigned& nloc, unsigned& nx, unsigned& uni) {
    const unsigned G = gridDim.x * gridDim.y * gridDim.z;
    unsigned sum, cnt, mine, sp = 0u, u32c;
    for (;;) {
        sum = 0u; cnt = 0u; mine = 0u; u32c = 0u;
#pragma unroll
        for (unsigned j = 0; j < 16; ++j) { const unsigned c = xb_ld(&bar[XB_XCNT(j)]); sum += c; cnt += (c > 0u) ? 1u : 0u; mine = (j == x) ? c : mine; u32c += (j < 8u && c == 32u) ? 1u : 0u; }
        if (sum == G) break;
        __builtin_amdgcn_s_sleep(1);
        if ((++sp & 255u) == 0u) { if (xb_ld(&bar[XB_TMO])) break; if (sp > XB_SPIN_CAP) { atomicAdd(&bar[XB_TMO], 1u); break; } }
    }
    nloc = mine > 0u ? mine : 1u; nx = cnt > 0u ? cnt : 1u;
    uni = (sum == G && G == 256u && cnt == 8u && u32c == 8u) ? 1u : 0u;
}
__device__ __forceinline__ void xcd_barrier(const XcdBarrier& b) {
    asm volatile("s_waitcnt vmcnt(0)" ::: "memory");
    __syncthreads();
    if (threadIdx.x == 0) {
        unsigned* bar = b.bar;
        __builtin_amdgcn_s_waitcnt(0);
        unsigned nloc = b.st[0], nx = b.st[1];
        if (nloc == 0u) { unsigned uni; xcd_barrier_complete(bar, b.x, nloc, nx, uni); b.st[0] = nloc; b.st[1] = nx; b.st[3] = uni; }
        const unsigned old = xb_add(&bar[XB_XSUB(b.x)], 1u);
        const unsigned gen = old / nloc;
        if (old + 1u == (gen + 1u) * nloc) {
            __builtin_amdgcn_fence(__ATOMIC_RELEASE, "agent");
            asm volatile("s_waitcnt vmcnt(0)" ::: "memory");
            const unsigned og = xb_add(&bar[XB_TOP], 1u);
            const unsigned tg = og / nx;
            if (og + 1u == (tg + 1u) * nx) xb_add(&bar[XB_TOPGEN], 1u);
            else XB_SPIN(xb_ld(&bar[XB_TOPGEN]) == tg, bar);
            __builtin_amdgcn_fence(__ATOMIC_ACQUIRE, "agent");
            xb_add(&bar[XB_XGEN(b.x)], 1u);
            asm volatile("s_waitcnt vmcnt(0)" ::: "memory");
        } else {
            XB_SPIN(xb_ld(&bar[XB_XGEN(b.x)]) == gen, bar);
            __builtin_amdgcn_fence(__ATOMIC_ACQUIRE, "agent");
            asm volatile("s_waitcnt vmcnt(0)" ::: "memory");
        }
    }
    __syncthreads();
}

__device__ __forceinline__ void xcd_barrier_local(const XcdBarrier& b) {
    asm volatile("s_waitcnt vmcnt(0)" ::: "memory");
    __syncthreads();
    if (threadIdx.x == 0) {
        unsigned* bar = b.bar;
        __builtin_amdgcn_s_waitcnt(0);
        const unsigned nloc = b.st[0];
        const unsigned old = xb_add(&bar[XB_XSUB(b.x)], 1u);
        const unsigned gen = old / nloc;
        if (old + 1u == (gen + 1u) * nloc) xb_add(&bar[XB_XGEN(b.x)], 1u);
        else XB_SPIN(xb_ld(&bar[XB_XGEN(b.x)]) == gen, bar);
        __builtin_amdgcn_fence(__ATOMIC_ACQUIRE, "agent");
        asm volatile("s_waitcnt vmcnt(0)" ::: "memory");
    }
    __syncthreads();
}

constexpr int LDS_BYTES = 147456;
struct Args {
    const float* in[21]; float* out; unsigned char* ws; int ph_lo, ph_hi;
};
__device__ __forceinline__ float wave_sum(float v) {
#pragma unroll
    for (int o = 1; o < 64; o <<= 1) v += __shfl_xor(v, o);
    return v;
}
__device__ __forceinline__ void tr_item(const float* W, int K, int N, int k0, int n0, bf16_t* WT, int prow0, const float* g, LAS float* scr, int lane) {
#pragma unroll 8
    for (int i = 0; i < 32; ++i) { const int kk = 2 * i + (lane >> 5); float w = W[(size_t)(k0 + kk) * N + n0 + (lane & 31)]; if (g) w *= g[k0 + kk]; scr[kk * 33 + (lane & 31)] = w; }
    asm volatile("s_waitcnt lgkmcnt(0)" ::: "memory");
    const int c = lane & 7;
#pragma unroll
    for (int j = 0; j < 4; ++j) { const int n = (lane >> 3) + 8 * j; const LAS float* s = scr + (8 * c) * 33 + n;
        u32x4 o; o.x = cvt_pk_bf16(s[0 * 33], s[1 * 33]); o.y = cvt_pk_bf16(s[2 * 33], s[3 * 33]); o.z = cvt_pk_bf16(s[4 * 33], s[5 * 33]); o.w = cvt_pk_bf16(s[6 * 33], s[7 * 33]);
        *(u32x4*)(WT + (size_t)(prow0 + n) * K + k0 + 8 * c) = o; }
    asm volatile("s_waitcnt lgkmcnt(0)" ::: "memory");
}
__device__ __forceinline__ void tr_item64(const float* W, int K, int N, int k0, int n0, bf16_t* WT, int prow0, int prow1, const float* g, LAS float* scr, int lane) {
    f32x4 v[16]; const int kr = lane >> 4, n4 = (lane & 15) * 4;
#pragma unroll
    for (int i = 0; i < 16; ++i) v[i] = *(const f32x4*)(W + (size_t)(k0 + 4 * i + kr) * N + n0 + n4);
#pragma unroll
    for (int i = 0; i < 16; ++i) { const int k = 4 * i + kr; const float gs = g ? g[k0 + k] : 1.f; LAS float* d = scr + k * 65 + n4;
        d[0] = v[i][0] * gs; d[1] = v[i][1] * gs; d[2] = v[i][2] * gs; d[3] = v[i][3] * gs; }
    asm volatile("s_waitcnt lgkmcnt(0)" ::: "memory");
    const int c = lane >> 3;
#pragma unroll
    for (int j = 0; j < 8; ++j) { const int n = (lane & 7) + 8 * j; const LAS float* s = scr + (8 * c) * 65 + n;
        u32x4 o; o.x = cvt_pk_bf16(s[0 * 65], s[1 * 65]); o.y = cvt_pk_bf16(s[2 * 65], s[3 * 65]); o.z = cvt_pk_bf16(s[4 * 65], s[5 * 65]); o.w = cvt_pk_bf16(s[6 * 65], s[7 * 65]);
        *(u32x4*)(WT + (size_t)((j < 4) ? prow0 + n : prow1 + n - 32) * K + k0 + 8 * c) = o; }
    asm volatile("s_waitcnt lgkmcnt(0)" ::: "memory");
}
template <bool HALFW = false>
__device__ __forceinline__ void tr_item64_f8(const float* W, int K, int N, int k0, int n0, unsigned char* WT, int prow0, int prow1, const float* g, float sc, LAS float* scr, int lane) {
    f32x4 v[16]; const int kr = lane >> 4, n4 = (lane & 15) * 4;
#pragma unroll
    for (int i = 0; i < 16; ++i) { v[i] = (f32x4){0.f, 0.f, 0.f, 0.f}; if (!HALFW || n4 < 32) v[i] = __builtin_nontemporal_load((const f32x4*)(W + (size_t)(k0 + 4 * i + kr) * N + n0 + n4)); }
#pragma unroll
    for (int i = 0; i < 16; ++i) { const int k = 4 * i + kr; const float gs = (g ? g[k0 + k] : 1.f) * sc; LAS float* d = scr + k * 65 + n4;
        d[0] = v[i][0] * gs; d[1] = v[i][1] * gs; d[2] = v[i][2] * gs; d[3] = v[i][3] * gs; }
    asm volatile("s_waitcnt lgkmcnt(0)" ::: "memory");
    const int kc = lane >> 4;
#pragma unroll
    for (int j = 0; j < (HALFW ? 2 : 4); ++j) { const int n = (lane & 15) + 16 * j; const LAS float* sp = scr + (16 * kc) * 65 + n;
        u32x4 o; unsigned w_[4];
#pragma unroll
        for (int q = 0; q < 4; ++q) { int t = __builtin_amdgcn_cvt_pk_fp8_f32(sp[(4 * q) * 65], sp[(4 * q + 1) * 65], 0, false); t = __builtin_amdgcn_cvt_pk_fp8_f32(sp[(4 * q + 2) * 65], sp[(4 * q + 3) * 65], t, true); w_[q] = (unsigned)t; }
        o.x = w_[0]; o.y = w_[1]; o.z = w_[2]; o.w = w_[3];
        *(u32x4*)(WT + (size_t)((j < 2) ? prow0 + n : prow1 + n - 32) * K + k0 + 16 * kc) = o; }
    asm volatile("s_waitcnt lgkmcnt(0)" ::: "memory");
}
__device__ __forceinline__ void tr_item_f8(const float* W, int K, int N, int k0, int n0, unsigned char* WT, int prow0, const float* g, float sc, LAS float* scr, int lane) {
#pragma unroll 8
    for (int i = 0; i < 32; ++i) { const int kk = 2 * i + (lane >> 5); float w = W[(size_t)(k0 + kk) * N + n0 + (lane & 31)] * sc; if (g) w *= g[k0 + kk]; scr[kk * 33 + (lane & 31)] = w; }
    asm volatile("s_waitcnt lgkmcnt(0)" ::: "memory");
    const int n = lane & 31;
#pragma unroll
    for (int j = 0; j < 2; ++j) { const int kc = (lane >> 5) + 2 * j; const LAS float* sp = scr + (16 * kc) * 33 + n; unsigned w_[4];
#pragma unroll
        for (int q = 0; q < 4; ++q) { int t = __builtin_amdgcn_cvt_pk_fp8_f32(sp[(4 * q) * 33], sp[(4 * q + 1) * 33], 0, false); t = __builtin_amdgcn_cvt_pk_fp8_f32(sp[(4 * q + 2) * 33], sp[(4 * q + 3) * 33], t, true); w_[q] = (unsigned)t; }
        u32x4 o; o.x = w_[0]; o.y = w_[1]; o.z = w_[2]; o.w = w_[3];
        *(u32x4*)(WT + (size_t)(prow0 + n) * K + k0 + 16 * kc) = o; }
    asm volatile("s_waitcnt lgkmcnt(0)" ::: "memory");
}
struct WItem { const float* W; const float* g; unsigned char* WT; int N, k0, n0, Kb, p0, p1; float sc; bool halfw, f8, valid; };
__device__ __forceinline__ void witem_load(f32x4 (&v)[16], const WItem& d, int lane) {
    const int kr = lane >> 4, n4 = (lane & 15) * 4;
#pragma unroll
    for (int i = 0; i < 16; ++i) { v[i] = (f32x4){0.f, 0.f, 0.f, 0.f}; if (d.valid && (!d.halfw || n4 < 32)) v[i] = __builtin_nontemporal_load((const f32x4*)(d.W + (size_t)(d.k0 + 4 * i + kr) * d.N + d.n0 + n4)); }
}
__device__ __forceinline__ void witem_finish(const f32x4 (&v)[16], const WItem& d, LAS float* scr, int lane) {
    if (!d.valid) return;
    const int kr = lane >> 4, n4 = (lane & 15) * 4;
#pragma unroll
    for (int i = 0; i < 16; ++i) { const int k = 4 * i + kr; const float gs = (d.g ? d.g[d.k0 + k] : 1.f) * d.sc; LAS float* q = scr + k * 65 + n4;
        q[0] = v[i][0] * gs; q[1] = v[i][1] * gs; q[2] = v[i][2] * gs; q[3] = v[i][3] * gs; }
    asm volatile("s_waitcnt lgkmcnt(0)" ::: "memory");
    if (d.f8) { const int kc = lane >> 4;
#pragma unroll
        for (int j = 0; j < 4; ++j) { if (d.halfw && j >= 2) break; const int n = (lane & 15) + 16 * j; const LAS float* sp = scr + (16 * kc) * 65 + n; unsigned w_[4];
#pragma unroll
            for (int q = 0; q < 4; ++q) { int t = __builtin_amdgcn_cvt_pk_fp8_f32(sp[(4 * q) * 65], sp[(4 * q + 1) * 65], 0, false); t = __builtin_amdgcn_cvt_pk_fp8_f32(sp[(4 * q + 2) * 65], sp[(4 * q + 3) * 65], t, true); w_[q] = (unsigned)t; }
            u32x4 o; o.x = w_[0]; o.y = w_[1]; o.z = w_[2]; o.w = w_[3];
            *(u32x4*)(d.WT + (size_t)((j < 2) ? d.p0 + n : d.p1 + n - 32) * d.Kb + d.k0 + 16 * kc) = o; }
    } else { const int c = lane >> 3;
#pragma unroll
        for (int j = 0; j < 8; ++j) { const int n = (lane & 7) + 8 * j; const LAS float* sp = scr + (8 * c) * 65 + n;
            u32x4 o; o.x = cvt_pk_bf16(sp[0 * 65], sp[1 * 65]); o.y = cvt_pk_bf16(sp[2 * 65], sp[3 * 65]); o.z = cvt_pk_bf16(sp[4 * 65], sp[5 * 65]); o.w = cvt_pk_bf16(sp[6 * 65], sp[7 * 65]);
            *(u32x4*)(d.WT + (size_t)((j < 4) ? d.p0 + n : d.p1 + n - 32) * d.Kb + (size_t)(d.k0 + 8 * c) * 2) = o; }
    }
    asm volatile("s_waitcnt lgkmcnt(0)" ::: "memory");
}
__device__ __forceinline__ int win_prow(int n) {
    if (n < 1056) return n;
    if (n < 1568) return 1280 + (n - 1056);
    if (n < 1696) { const int j = n - 1568; return 1792 + ((j >> 5) & 1) * 128 + 32 * (j >> 6); }
    if (n < 1824) { const int j = n - 1696; return 1792 + ((j >> 5) & 1) * 128 + 32 * (2 + (j >> 6)); }
    return 2048 + (n - 1824);
}
__device__ __forceinline__ int block_scan(int v, int& tot, LAS int* scr, int tid) {
    const int lane = tid & 63, w = tid >> 6; int x = v;
#pragma unroll
    for (int o = 1; o < 64; o <<= 1) { const int y = __shfl_up(x, o); if (lane >= o) x += y; }
    __syncthreads();
    if (lane == 63) scr[w] = x;
    __syncthreads();
    int base = 0, t = 0;
#pragma unroll
    for (int i = 0; i < 8; ++i) { const int s = scr[i]; if (i < w) base += s; t += s; }
    tot = t; return base + x - v;
}

__global__ void __launch_bounds__(512, 2) fwd_kernel(const Args args) {
    extern __shared__ __attribute__((aligned(16))) unsigned char lds[];
    LAS unsigned char* ldsl = (LAS unsigned char*)lds;
    __builtin_assume(__builtin_amdgcn_workitem_id_y() == 0); __builtin_assume(__builtin_amdgcn_workitem_id_z() == 0);
    const int wave = __builtin_amdgcn_readfirstlane(threadIdx.x >> 6);
    const int G = gridDim.x; int bx = blockIdx.x;
#define PHASE_TID() int tid = threadIdx.x; asm volatile("" : "+v"(tid)); const int lane = tid & 63; (void)lane
    int vcu = (G % 8 == 0) ? (bx % 8) * (G / 8) + bx / 8 : bx;
    int gw = vcu * 8 + wave; const int NGW = G * 8;
    bool xloc = false;
#define AS4 __attribute__((address_space(4)))
#define PHASE_ARGS() const Args AS4* KA_ = (const Args AS4*)__builtin_amdgcn_kernarg_segment_ptr(); asm volatile("" : "+s"(KA_)); unsigned char* const ws = KA_->ws; (void)ws
#define INP(i) (KA_->in[i])
#define WSP(TY, off) ((TY*)(ws + (off)))
    const int lo = args.ph_lo, hi = args.ph_hi;
#define IN(k) (lo <= (k) && (k) < hi)
#if MK_CG
#define SEAM(k) do { if (IN(k) && IN((k) + 1)) { cg::this_grid().sync(); } } while (0)
#define SEAM_L(k) SEAM(k)
#else
    volatile LAS unsigned* bst = (volatile LAS unsigned*)(ldsl + LDS_BYTES - 64);
    if (threadIdx.x < 4) bst[threadIdx.x] = 0u;
    __syncthreads();
    XcdBarrier xbar;
    { unsigned* barw = (unsigned*)(args.ws + WS_CTL) + 4096; xbar = xcd_barrier_post(barw, bst); }
#define SEAM(k) do { if (IN(k) && IN((k) + 1)) { xcd_barrier(xbar); } } while (0)
#define SEAM_L(k) do { if (IN(k) && IN((k) + 1)) { if (xloc) xcd_barrier_local(xbar); else xcd_barrier(xbar); } } while (0)
#endif

    if (IN(0)) REPS(0) {
        PHASE_TID(); PHASE_ARGS();
        const float* x = INP(0); const float* g_attn = INP(1); const float* w_in = INP(2); const float* g_q_lat = INP(4); const float* w_q_up = INP(5); const float* g_kv_lat = INP(6); const float* w_kv_up = INP(7);
        const float* w_mla_br = INP(12); const float* w_gqa_br = INP(13); const float* w_out = INP(14);
        bf16_t* Win_t = WSP(bf16_t, WS_WIN); bf16_t* Wqup_t = WSP(bf16_t, WS_WQUP); bf16_t* Wkvup_t = WSP(bf16_t, WS_WKVUP); bf16_t* Wa_t = WSP(bf16_t, WS_WA); bf16_t* Wb_t = WSP(bf16_t, WS_WB); bf16_t* Wo_t = WSP(bf16_t, WS_WO);
        bf16_t* XB = WSP(bf16_t, WS_XB); float* RINV1 = WSP(float, WS_RINV1); bf16_t* XH = WSP(bf16_t, WS_XH);
        for (int i = gw * 64 + lane; i < 64 * 16 + 64 * 8; i += NGW * 64) {
            const bool big = i < 1024; const int j = big ? i : i - 1024, pos = big ? (j >> 4) : (j >> 3), f = big ? (j & 15) : (j & 7);
            float sn, cs; rope_cs((float)pos, f, big ? 0.0625f : 0.125f, sn, cs);
            float* tp = (big ? WSP(float, WS_ROPE16) : WSP(float, WS_ROPE8)) + 2 * j; tp[0] = cs; tp[1] = sn; }
        for (int i = gw * 64 + lane; i < 224 * 64; i += NGW * 64) *(u32x4*)((unsigned char*)Win_t + (size_t)1056 * 1024 + (size_t)i * 16) = (u32x4){0u, 0u, 0u, 0u};
        constexpr int I_IN = 16 * 61, I_QUP = 12 * 12, I_KVUP = 4 * 16, I_BR = 8 * 16, I_O = 16 * 16;
        constexpr int NITEMS = I_IN + I_QUP + I_KVUP + 2 * I_BR + I_O;
#define P0_DECODE(d, it_) do { int r = (it_); d.valid = r < NITEMS; d.halfw = false; d.f8 = true; d.sc = 32.f; d.g = nullptr; d.N = 1024; d.Kb = 1024; \
            if (r < I_IN) { const int kb = r / 61, nb = r % 61; d.W = w_in; d.N = 3872; d.k0 = kb * 64; d.n0 = nb * 64; d.g = g_attn; d.WT = (unsigned char*)Win_t; d.halfw = nb == 60; d.p0 = win_prow(nb * 64); d.p1 = (nb == 60) ? 0 : win_prow(nb * 64 + 32); } \
            else if ((r -= I_IN) < I_QUP) { const int kb = r / 12, nb = r % 12; d.W = w_q_up; d.N = 768; d.k0 = kb * 64; d.n0 = nb * 64; d.g = g_q_lat; d.WT = (unsigned char*)Wqup_t; d.Kb = 768; d.p0 = nb * 64; d.p1 = nb * 64 + 32; }     \
            else if ((r -= I_QUP) < I_KVUP) { const int kb = r / 16, nb = r % 16, n2 = 2 * nb;     \
                d.W = w_kv_up; d.k0 = kb * 64; d.n0 = nb * 64; d.g = g_kv_lat; d.WT = (unsigned char*)Wkvup_t; d.Kb = 256 * 2; d.f8 = false; d.sc = 1.f; d.p0 = ((n2 >> 3) * 256) + 32 * (2 * ((n2 >> 2) & 1) + ((n2 >> 1) & 1)); d.p1 = d.p0 + 128; } \
            else if ((r -= I_KVUP) < 2 * I_BR) { const int hb = r / I_BR, q = r % I_BR, kb = q / 16, nb = q % 16;     \
                d.W = hb ? w_gqa_br : w_mla_br; d.k0 = kb * 64; d.n0 = nb * 64; d.WT = (unsigned char*)Wa_t + hb * 512; d.p0 = nb * 64; d.p1 = nb * 64 + 32; } \
            else { r -= 2 * I_BR; const int kb = r / 16, nb = r % 16; d.W = w_out; d.k0 = kb * 64; d.n0 = nb * 64; d.WT = (unsigned char*)Wo_t; d.p0 = nb * 64; d.p1 = nb * 64 + 32; } } while (0)
        WItem wd; f32x4 wv[16]; P0_DECODE(wd, gw); witem_load(wv, wd, lane);
#define P0_LOAD(V, m_) do { _Pragma("unroll") for (int r = 0; r < 4; ++r) { const f32x4* xr = (const f32x4*)(x + (size_t)((m_) + r) * DM) + lane; \
            _Pragma("unroll") for (int j = 0; j < 4; ++j) V[r][j] = __builtin_nontemporal_load(xr + 64 * j); } } while (0)
#define P0_PROC(V, m_) do { _Pragma("unroll") for (int r = 0; r < 4; ++r) { float s_ = 0.f; \
            _Pragma("unroll") for (int j = 0; j < 4; ++j) s_ += (V[r][j][0] * V[r][j][0] + V[r][j][1] * V[r][j][1]) + (V[r][j][2] * V[r][j][2] + V[r][j][3] * V[r][j][3]); \
            s_ = wave_sum(s_); \
            if (lane == 0) RINV1[(m_) + r] = 1.0f / sqrtf(s_ * (1.0f / DM) + EPS); \
            unsigned* o4 = (unsigned*)((unsigned char*)XB + (size_t)((m_) + r) * DM) + lane;        \
            u32x2* h4 = (u32x2*)(XH + (size_t)((m_) + r) * DM) + lane;                                \
            _Pragma("unroll") for (int j = 0; j < 4; ++j) { int t = __builtin_amdgcn_cvt_pk_fp8_f32(V[r][j][0], V[r][j][1], 0, false); t = __builtin_amdgcn_cvt_pk_fp8_f32(V[r][j][2], V[r][j][3], t, true); o4[64 * j] = (unsigned)t; h4[64 * j] = pack4_f16(V[r][j]); } } } while (0)
        {   f32x4 va[4][4], vb[4][4]; constexpr int RS = 4; const int mstep = NGW * RS; int m0 = gw * RS;
            if (m0 < T) P0_LOAD(va, m0);
#pragma unroll 1
            for (; m0 < T; m0 += 2 * mstep) {
                if (m0 + mstep < T) P0_LOAD(vb, m0 + mstep);
                P0_PROC(va, m0);
                if (m0 + 2 * mstep < T) P0_LOAD(va, m0 + 2 * mstep);
                if (m0 + mstep < T) P0_PROC(vb, m0 + mstep);
            }
        }
#undef P0_LOAD
#undef P0_PROC
        {   LAS float* scr = (LAS float*)(ldsl + wave * 16640);
            witem_finish(wv, wd, scr, lane);
            for (int it = gw + NGW; it < NITEMS; it += NGW) { P0_DECODE(wd, it); witem_load(wv, wd, lane); witem_finish(wv, wd, scr, lane); }
        }
#undef P0_DECODE
        __syncthreads();
    }
    SEAM(0);
#if !MK_CG
    if (IN(0) && IN(1)) {
        const unsigned uni = __builtin_amdgcn_readfirstlane(bst[3]), rk = __builtin_amdgcn_readfirstlane(bst[2]);
        if (uni != 0u && rk < 32u && xbar.x < 8u) { xloc = true; bx = (int)(rk * 8u + xbar.x); vcu = (bx % 8) * (G / 8) + bx / 8; gw = vcu * 8 + wave; }
    }
#endif
    if (IN(1)) REPS(1) {
        PHASE_ARGS();
        pg8::Gemm g{WSP(bf16_t, WS_XB), WSP(bf16_t, WS_WIN), nullptr}; pg8::TileOrder<T, 4096, 0, 1> S; S.init(G, bx);
        { PHASE_TID(); LAS float* tl = (LAS float*)(ldsl + 131072); const float* tg = WSP(float, WS_ROPE16);
          for (int i = tid; i < 64 * 16 * 2; i += 512) tl[i] = tg[i];
          __syncthreads(); }
        pg8::EpiProj E{WSP(float, WS_RINV1), WSP(unsigned char, WS_LQ8), WSP(bf16_t, WS_LAT), WSP(float, WS_SSQ), WSP(bf16_t, WS_QB), WSP(bf16_t, WS_KB), WSP(bf16_t, WS_VB), WSP(unsigned char, WS_GATES), INP(3), INP(11), (const LAS float*)(ldsl + 131072)};
        pg8::gemm_phase<1024, 1024, false, 1>(ldsl, g, S, E);
    }
    SEAM_L(1);
    if (IN(2)) REPS(2) {
        { PHASE_ARGS(); pg8::Gemm g{WSP(bf16_t, WS_LQ8), WSP(bf16_t, WS_WQUP), nullptr}; pg8::TileOrder<T, 768, 0> S; S.init(G, bx); pg8::EpiQup E{WSP(float, WS_SSQ), WSP(bf16_t, WS_QA)}; pg8::gemm_phase<QL, QL, false, 1>(ldsl, g, S, E); }
        { PHASE_ARGS(); { PHASE_TID(); LAS float* tl = (LAS float*)(ldsl + 131072); const float* tg = WSP(float, WS_ROPE8); for (int i = tid; i < 64 * 8 * 2; i += 512) tl[i] = tg[i]; __syncthreads(); }
          pg8::Gemm g{WSP(bf16_t, WS_LAT) + QL, WSP(bf16_t, WS_WKVUP), nullptr}; pg8::TileOrder<T, 1024, 0> S; S.init(G, bx); pg8::EpiKVup E{WSP(float, WS_SSQ), WSP(bf16_t, WS_LAT), INP(9), (const LAS float*)(ldsl + 131072), WSP(bf16_t, WS_KA), WSP(bf16_t, WS_VA)}; pg8::gemm_phase<KVL, LATW>(ldsl, g, S, E); }
    }
    SEAM_L(2);
    if (IN(4)) REPS(4) {
        PHASE_ARGS();
        const bf16_t* Qa = WSP(bf16_t, WS_QA); const bf16_t* Ka = WSP(bf16_t, WS_KA); const bf16_t* Va = WSP(bf16_t, WS_VA); const bf16_t* Qb = WSP(bf16_t, WS_QB); const bf16_t* Kb = WSP(bf16_t, WS_KB); const bf16_t* Vb = WSP(bf16_t, WS_VB); unsigned char* Y8 = WSP(unsigned char, WS_XB);
        float mref96, mref64;
        { PHASE_TID(); const float* gq = INP(8); const float* gk = INP(9); const float* hq = INP(10); const float* hk = INP(11);
          float a = fmaxf(fabsf(gq[lane]), (lane < 32) ? fabsf(gq[64 + lane]) : 0.f), b = fmaxf(fabsf(gk[lane]), (lane < 32) ? fabsf(gk[64 + lane]) : 0.f), c = fabsf(hq[lane]), d = fabsf(hk[lane]);
#pragma unroll
          for (int o = 1; o < 64; o <<= 1) { a = fmaxf(a, __shfl_xor(a, o)); b = fmaxf(b, __shfl_xor(b, o)); c = fmaxf(c, __shfl_xor(c, o)); d = fmaxf(d, __shfl_xor(d, o)); }
          mref96 = __builtin_amdgcn_readfirstlane(__float_as_uint(1.02f * 9.797958971f * 1.4426950409f * a * b)); mref96 = __uint_as_float(__builtin_amdgcn_readfirstlane(__float_as_uint(1.02f * 9.797958971f * 1.4426950409f * a * b)));
          mref64 = __uint_as_float(__builtin_amdgcn_readfirstlane(__float_as_uint(1.02f * 8.0f * 1.4426950409f * c * d))); }
        const bool fast96 = mref96 <= 60.f, fast64 = mref64 <= 60.f;
#define ATT_MLA(bh_, qb_) do { const int b_ = (bh_) >> 3, h_ = (bh_) & 7; const bf16_t* q_ = Qa + ((size_t)(bh_) * SEQ + (qb_) * 256) * 96; const unsigned char* k_ = (const unsigned char*)Ka + (size_t)(bh_) * SEQ * 96; \
        const bf16_t* v_ = Va + (size_t)(bh_) * SEQ * 64; unsigned char* o_ = Y8 + ((size_t)b_ * SEQ + (qb_) * 256) * DM + h_ * 64; \
        if (fast96) att::attn_unit4<96, 1024, false>(q_, k_, v_, o_, SEQ, (LAS char*)ldsl, 0.f, INP(8), WSP(float, WS_ROPE8), (qb_) * 256); \
        else att::attn_unit4<96, 1024, true>(q_, k_, v_, o_, SEQ, (LAS char*)ldsl, -mref96, INP(8), WSP(float, WS_ROPE8), (qb_) * 256); } while (0)
#define ATT_GQA(bh_, qb_) do { const int b_ = (bh_) >> 3, h_ = (bh_) & 7, kvh_ = h_ >> 2; const bf16_t* q_ = Qb + ((size_t)(bh_) * SEQ + (qb_) * 256) * 64; const unsigned char* k_ = (const unsigned char*)Kb + (size_t)(b_ * 2 + kvh_) * SEQ * 64; \
        const bf16_t* v_ = Vb + (size_t)(b_ * 2 + kvh_) * SEQ * 64; unsigned char* o_ = Y8 + ((size_t)b_ * SEQ + (qb_) * 256) * DM + 512 + h_ * 64; \
        if (fast64) att::attn_unit4<64, 1024, false>(q_, k_, v_, o_, SEQ, (LAS char*)ldsl, 0.f, INP(10), WSP(float, WS_ROPE16), (qb_) * 256); \
        else att::attn_unit4<64, 1024, true>(q_, k_, v_, o_, SEQ, (LAS char*)ldsl, -mref64, INP(10), WSP(float, WS_ROPE16), (qb_) * 256); } while (0)
        if (G == 256) {
            const int xcd = bx % 8, v = bx / 8, slot = v >> 4, qb = v & 15;
            for (int r = 0; r < 4; ++r) ATT_MLA(xcd * 8 + 2 * r + slot, qb);
            for (int r = 0; r < 4; ++r) ATT_GQA(xcd * 8 + 2 * r + slot, qb);
        } else {
            for (int uix = bx; uix < 2048; uix += G) { const int r = uix & 1023; if (uix < 1024) ATT_MLA(r >> 4, r & 15); else ATT_GQA(r >> 4, r & 15); }
        }
#undef ATT_MLA
#undef ATT_GQA
    }
    SEAM_L(4);
    if (IN(5)) REPS(5) {
        PHASE_ARGS(); pg8::Gemm g{WSP(bf16_t, WS_XB), WSP(bf16_t, WS_WA), nullptr}; pg8::TileOrder<T, 1024, 0> S; S.init(G, bx); pg8::EpiMerge2 E{WSP(unsigned char, WS_GATES), WSP(unsigned char, WS_MG)};
        pg8::gemm_phase<1024, 1024, false, 1>(ldsl, g, S, E);
    }
    SEAM_L(5);
    if (IN(6)) REPS(6) {
        PHASE_ARGS();
        pg8::Gemm g{WSP(bf16_t, WS_MG), WSP(bf16_t, WS_WO), nullptr}; pg8::TileOrder<T, 1024, 0> S; S.init(G, bx); pg8::EpiOut E{WSP(bf16_t, WS_XH), WSP(bf16_t, WS_X1H), WSP(unsigned char, WS_XB)};
        pg8::gemm_phase<1024, 1024, false, 1>(ldsl, g, S, E);
    }
    SEAM_L(6);
    if (IN(7)) REPS(7) {
        PHASE_TID(); PHASE_ARGS();
        const float* g_ffn = INP(15); const float* w_router = INP(16); const float* b_router = INP(17); const bf16_t* x1h = WSP(bf16_t, WS_X1H); float* AFF = WSP(float, WS_AFF); float* RINV2 = WSP(float, WS_RINV2);
        LAS float* WR = (LAS float*)ldsl;
        const int li = lane & 15, kq = lane >> 4;
        u32x4 xa[8], xb[8];
        {
            if (gw < T / 16) { const u32x4* xp0 = (const u32x4*)(x1h + (size_t)(gw * 16 + li) * DM) + kq;
#pragma unroll
                for (int q = 0; q < 8; ++q) xa[q] = xp0[4 * q]; }
            f32x4 w4[8]; float g1[8];
#pragma unroll
            for (int j = 0; j < 8; ++j) { const int i = 4 * (tid + 512 * j); w4[j] = *(const f32x4*)(w_router + i); g1[j] = g_ffn[i >> 4]; }
#pragma unroll
            for (int j = 0; j < 8; ++j) { const int i = 4 * (tid + 512 * j), k = i >> 4, e = i & 15, rho = (k & ~31) | ((k & 7) << 2) | ((k >> 3) & 3); *(LAS f32x4*)(WR + rho * 16 + e) = w4[j] * g1[j]; }
        }
        __syncthreads();
        const float be = b_router[li];
        for (int tile = gw; tile < T / 16; tile += NGW) {
            const int row0 = tile * 16;
            const u32x4* xp = (const u32x4*)(x1h + (size_t)(row0 + li) * DM) + kq;
            f32x4 acc = {0.f, 0.f, 0.f, 0.f}; float ss = 0.f;
            const LAS float* wl = WR + kq * 16 + li;
            if (tile != gw) {
#pragma unroll
                for (int q = 0; q < 8; ++q) xa[q] = xp[4 * q]; }
#pragma unroll 1
            for (int c = 0; c < 4; c += 2) {
#pragma unroll
                for (int q = 0; q < 8; ++q) xb[q] = xp[4 * ((c + 1) * 8 + q)];
#pragma unroll
                for (int q = 0; q < 8; ++q) { const int j = c * 8 + q; f32x4 f0, f1; unpack8_f16(xa[q], f0, f1);
#pragma unroll
                    for (int t = 0; t < 8; ++t) { const float a = (t < 4) ? f0[t & 3] : f1[t & 3]; ss += a * a; acc = __builtin_amdgcn_mfma_f32_16x16x4f32(a, wl[(32 * j + 4 * t) * 16], acc, 0, 0, 0); } }
                if (c + 2 < 4) {
#pragma unroll
                    for (int q = 0; q < 8; ++q) xa[q] = xp[4 * ((c + 2) * 8 + q)]; }
#pragma unroll
                for (int q = 0; q < 8; ++q) { const int j = (c + 1) * 8 + q; f32x4 f0, f1; unpack8_f16(xb[q], f0, f1);
#pragma unroll
                    for (int t = 0; t < 8; ++t) { const float a = (t < 4) ? f0[t & 3] : f1[t & 3]; ss += a * a; acc = __builtin_amdgcn_mfma_f32_16x16x4f32(a, wl[(32 * j + 4 * t) * 16], acc, 0, 0, 0); } }
            }
            ss += __shfl_xor(ss, 16); ss += __shfl_xor(ss, 32);
            const float ri = 1.0f / sqrtf(ss * (1.0f / DM) + EPS);
            if (kq == 0) RINV2[row0 + li] = ri;
#pragma unroll
            for (int r = 0; r < 4; ++r) {
                const int R = 4 * kq + r; const float rr = __shfl(ri, R);
                const float lg = acc[r] * rr + be;
                float mx = lg;
#pragma unroll
                for (int o = 1; o < 16; o <<= 1) mx = fmaxf(mx, __shfl_xor(mx, o));
                const float ex = __expf(lg - mx); float den = ex;
#pragma unroll
                for (int o = 1; o < 16; o <<= 1) den += __shfl_xor(den, o);
                const int m = row0 + R, b = m >> 12, s_ = m & 4095;
                AFF[((size_t)(b * 16 + li)) * SEQ + s_] = ex / den;
            }
        }
        __syncthreads();
    }
    SEAM_L(7);
    if (IN(8)) REPS(8) {
        PHASE_TID(); PHASE_ARGS();
        const float* g_ffn = INP(15); const float* w_eg = INP(18); const float* w_eu = INP(19); const float* w_ed = INP(20);
        const float* AFF = WSP(float, WS_AFF); const float* RINV2 = WSP(float, WS_RINV2); int* IDX = WSP(int, WS_IDX); float* GATEV = WSP(float, WS_GATEV); float* RG = WSP(float, WS_RG); int* INV = WSP(int, WS_INV);
        unsigned char* Wgu8 = WSP(unsigned char, WS_WGU); unsigned char* Wd8 = WSP(unsigned char, WS_WD);
        for (int p0_ = bx; p0_ < BATCH * NEXP; p0_ += G) {
            const int p = (G == 256) ? (p0_ % 8) * 16 + p0_ / 8 : p0_;
            LAS unsigned* keys = (LAS unsigned*)ldsl;
            LAS int* hist = (LAS int*)(ldsl + 16384);
            LAS int* scr = (LAS int*)(ldsl + 16384 + 1024);
            const int b = p >> 4, e = p & 15;
            const unsigned* ap = (const unsigned*)(AFF + (size_t)p * SEQ);
            for (int i = tid; i < SEQ; i += 512) keys[i] = ap[i];
            __syncthreads();
            unsigned prefix = 0u, pmask = 0u; int want = CAP;
            for (int pass = 0; pass < 4; ++pass) {
                const int shift = 24 - 8 * pass;
                if (tid < 256) hist[tid] = 0;
                __syncthreads();
                for (int i = tid; i < SEQ; i += 512) { const unsigned k = keys[i]; if ((k & pmask) == prefix) atomicAdd((int*)&hist[(k >> shift) & 255u], 1); }
                __syncthreads();
                if (tid < 64) {
                    const int c0 = hist[255 - 4 * tid], c1 = hist[254 - 4 * tid], c2 = hist[253 - 4 * tid], c3 = hist[252 - 4 * tid]; const int sm = (c0 + c1) + (c2 + c3);
                    int inc = sm;
#pragma unroll
                    for (int o = 1; o < 64; o <<= 1) { const int y = __shfl_up(inc, o); if (tid >= o) inc += y; }
                    const int exc = inc - sm;
                    if (exc < want && want <= inc) { int cum = exc, d = 255 - 4 * tid;
                        if (cum + c0 < want) { cum += c0; --d; if (cum + c1 < want) { cum += c1; --d; if (cum + c2 < want) { cum += c2; --d; } } }
                        scr[16] = d; scr[17] = want - cum; }
                }
                __syncthreads();
                const int d = scr[16]; want = scr[17];
                prefix |= ((unsigned)d) << shift; pmask |= 255u << shift;
                __syncthreads();
            }
            const unsigned thr = prefix; const int need_eq = want;
            unsigned kv[8]; int ceq = 0;
#pragma unroll
            for (int j = 0; j < 8; ++j) { kv[j] = keys[tid * 8 + j]; ceq += (kv[j] == thr) ? 1 : 0; }
            int toteq; int eqbase = block_scan(ceq, toteq, scr, tid);
            int csel = 0; unsigned selmask = 0u;
#pragma unroll
            for (int j = 0; j < 8; ++j) { bool sel = kv[j] > thr; if (kv[j] == thr) { sel = eqbase < need_eq; ++eqbase; } if (sel) { selmask |= 1u << j; ++csel; } }
            int totsel; int slot = block_scan(csel, totsel, scr, tid);
#pragma unroll
            for (int j = 0; j < 8; ++j) { const int s = tid * 8 + j; int iv = -1;
                if (selmask & (1u << j)) { iv = slot; IDX[(e * 8 + b) * CAP + slot] = b * SEQ + s; GATEV[(size_t)(e * 8 + b) * CAP + slot] = __uint_as_float(kv[j]); RG[(size_t)(e * 8 + b) * CAP + slot] = RINV2[b * SEQ + s]; ++slot; }
                INV[((size_t)b * SEQ + s) * 16 + e] = iv; }
            __syncthreads();
        }
        { LAS float* scr = (LAS float*)(ldsl + wave * 16640);
          constexpr int IPM = 16 * 16, NTICK = 48 * IPM / 8;
#define P8_ITEM(it_) do { const int it = (it_); const int mtx = it / IPM, r = it % IPM, kb = r / 16, nb = r % 16, e = mtx % 16, kind = mtx / 16, n0 = nb * 64; \
              if (kind == 0)      tr_item64_f8(w_eg + (size_t)e * DM * FF, 1024, 1024, kb * 64, n0, Wgu8 + (size_t)e * 2048 * 1024, (n0 >> 7) * 256 + (n0 & 127), (n0 >> 7) * 256 + (n0 & 127) + 32, g_ffn, 64.f, scr, lane); \
              else if (kind == 1) tr_item64_f8(w_eu + (size_t)e * DM * FF, 1024, 1024, kb * 64, n0, Wgu8 + (size_t)e * 2048 * 1024, (n0 >> 7) * 256 + 128 + (n0 & 127), (n0 >> 7) * 256 + 128 + (n0 & 127) + 32, g_ffn, 64.f, scr, lane); \
              else                tr_item64_f8(w_ed + (size_t)e * FF * DM, 1024, 1024, kb * 64, n0, Wd8 + (size_t)e * 1024 * 1024, n0, n0 + 32, nullptr, 64.f, scr, lane); } while (0)
          if (G == 256) {
              unsigned* qctr = (unsigned*)(ws + WS_CTL) + 12288;
              volatile LAS unsigned* tk = (volatile LAS unsigned*)(ldsl + LDS_BYTES - 128);
              __syncthreads();
              if (tid == 0) tk[0] = xb_add(qctr, 1u);
              __syncthreads();
              unsigned cur = tk[0];
              while (cur < (unsigned)NTICK) {
                  unsigned nxt = 0u; if (tid == 0) nxt = xb_add(qctr, 1u);
                  P8_ITEM((int)cur * 8 + wave);
                  __syncthreads();
                  if (tid == 0) tk[0] = nxt;
                  __syncthreads();
                  cur = tk[0];
              }
          } else { for (int it = gw; it < 48 * IPM; it += NGW) P8_ITEM(it); }
#undef P8_ITEM
        }
        __syncthreads();
    }
    SEAM(8);
    if (IN(10)) REPS(10) {
        PHASE_ARGS();
        pg8::Gemm g{WSP(bf16_t, WS_XB), WSP(bf16_t, WS_WGU), WSP(int, WS_IDX)};
        pg8::TileOrder<NEXP * BATCH * CAP, 2048, 16> S; S.init(G, bx); pg8::EpiSwiGLU E{WSP(float, WS_RG), WSP(unsigned char, WS_ACT)};
        pg8::gemm_phase<1024, 1024, true, 1>(ldsl, g, S, E);
    }
    SEAM_L(10);
    if (IN(11)) REPS(11) {
        PHASE_ARGS();
        pg8::Gemm g{WSP(bf16_t, WS_ACT), WSP(bf16_t, WS_WD), nullptr}; pg8::TileOrder<NEXP * BATCH * CAP, 1024, 16> S; S.init(G, bx); pg8::EpiDown E{WSP(float, WS_GATEV), WSP(unsigned char, WS_XE)};
        pg8::gemm_phase<1024, 1024, false, 1>(ldsl, g, S, E);
    }
    SEAM(11);
    if (IN(12)) REPS(12) {
        PHASE_TID(); PHASE_ARGS();
        const int* INV = WSP(int, WS_INV); const unsigned char* YE = WSP(unsigned char, WS_XE); float* out = KA_->out; const bf16_t* x1h = WSP(bf16_t, WS_X1H);
        constexpr int RS = 4; int m0 = gw * RS; int ninv[RS];
#pragma unroll
        for (int r = 0; r < RS; ++r) ninv[r] = (lane < 16 && m0 < T) ? INV[(size_t)(m0 + r) * 16 + lane] : -1;
#pragma unroll 1
        for (; m0 < T; m0 += NGW * RS) {
            const int b = m0 >> 12;
            int myinv[RS]; u32x4 xh[RS][2]; unsigned long long mask[RS];
#pragma unroll
            for (int r = 0; r < RS; ++r) { myinv[r] = ninv[r]; const bf16_t* xrow = x1h + (size_t)(m0 + r) * DM;
                xh[r][0] = __builtin_nontemporal_load((const u32x4*)(xrow + lane * 8)); xh[r][1] = __builtin_nontemporal_load((const u32x4*)(xrow + 512 + lane * 8)); }
#pragma unroll
            for (int r = 0; r < RS; ++r) mask[r] = __ballot(myinv[r] >= 0);
            u32x2 y[RS][2][2]; int cnt[RS];
#define P12_GATHER() do { _Pragma("unroll") for (int r = 0; r < RS; ++r) { cnt[r] = 0; \
                _Pragma("unroll") for (int q = 0; q < 2; ++q) { if (mask[r]) { const int e = __builtin_ctzll(mask[r]); mask[r] &= mask[r] - 1; const int sl = __shfl(myinv[r], e); \
                    const unsigned char* yr = YE + ((size_t)(e * 8 + b) * CAP + sl) * DM; y[r][q][0] = __builtin_nontemporal_load((const u32x2*)(yr + lane * 8)); y[r][q][1] = __builtin_nontemporal_load((const u32x2*)(yr + 512 + lane * 8)); cnt[r] = q + 1; } } } } while (0)
#define P12_ADD() do { _Pragma("unroll") for (int r = 0; r < RS; ++r) _Pragma("unroll") for (int q = 0; q < 2; ++q) { if (q < cnt[r]) { f32x4 y0, y1, y2, y3; unpack8_fp8(y[r][q][0], y0, y1); unpack8_fp8(y[r][q][1], y2, y3); \
                    ac[r][0] += y0 * 0.015625f; ac[r][1] += y1 * 0.015625f; ac[r][2] += y2 * 0.015625f; ac[r][3] += y3 * 0.015625f; } } } while (0)
            P12_GATHER();
            { const int mn = m0 + NGW * RS;
#pragma unroll
              for (int r = 0; r < RS; ++r) ninv[r] = (lane < 16 && mn < T) ? INV[(size_t)(mn + r) * 16 + lane] : -1; }
            f32x4 ac[RS][4];
#pragma unroll
            for (int r = 0; r < RS; ++r) { unpack8_f16(xh[r][0], ac[r][0], ac[r][1]); unpack8_f16(xh[r][1], ac[r][2], ac[r][3]); }
            P12_ADD();
            while ((mask[0] | mask[1]) | (mask[2] | mask[3])) { P12_GATHER(); P12_ADD(); }
#undef P12_GATHER
#undef P12_ADD
#pragma unroll
            for (int r = 0; r < RS; ++r) { float* orow = out + (size_t)(m0 + r) * DM;
                if (PROBE_PH == 12 && rp_ + 1 < PROBE_REPS) orow = WSP(float, WS_ACT) + (size_t)(m0 + r) * DM;
                __builtin_nontemporal_store(ac[r][0], (f32x4*)(orow + lane * 8)); __builtin_nontemporal_store(ac[r][1], (f32x4*)(orow + lane * 8 + 4)); __builtin_nontemporal_store(ac[r][2], (f32x4*)(orow + 512 + lane * 8)); __builtin_nontemporal_store(ac[r][3], (f32x4*)(orow + 512 + lane * 8 + 4)); }
        }
    }
#undef IN
#undef SEAM
#undef SEAM_L
}


extern "C" void kernel_launch(void* const* d_in, const int* in_sizes, int n_in, void* d_out, int out_size, void* d_ws, size_t ws_size, hipStream_t stream) {
    static int grid = 0;
    if (grid == 0) {
        if (n_in != 21 || in_sizes[0] != T * DM || out_size != T * DM || ws_size < WS_END) {
            fprintf(stderr, "kernel_launch: unexpected shapes: n_in %d in0 %d out %d ws %zu (need >= %zu)\n", n_in, n_in > 0 ? in_sizes[0] : -1, out_size, ws_size, (size_t)WS_END); grid = -1; return; }
        int dev = 0, cus = 0, per_cu = 0;
        if (hipGetDevice(&dev) != hipSuccess || hipDeviceGetAttribute(&cus, hipDeviceAttributeMultiprocessorCount, dev) != hipSuccess) { grid = -1; return; }
        if (hipFuncSetAttribute((const void*)fwd_kernel, hipFuncAttributeMaxDynamicSharedMemorySize, LDS_BYTES) != hipSuccess) { fprintf(stderr, "kernel_launch: hipFuncSetAttribute failed\n"); grid = -1; return; }
        if (hipOccupancyMaxActiveBlocksPerMultiprocessor(&per_cu, (const void*)fwd_kernel, 512, LDS_BYTES) != hipSuccess || per_cu < 1) { fprintf(stderr, "kernel_launch: occupancy query gave %d\n", per_cu); per_cu = 1; }
        (void)hipGetLastError();
        grid = cus;
    }
    if (grid < 0) return;
    Args a{};
    for (int i = 0; i < 21; ++i) a.in[i] = (const float*)d_in[i];
    a.out = (float*)d_out; a.ws = (unsigned char*)d_ws;
#if MK_MULTI
    for (int p = 0; p < NPH; ++p) { a.ph_lo = p; a.ph_hi = p + 1; hipLaunchKernelGGL(fwd_kernel, dim3(grid), dim3(512), LDS_BYTES, stream, a); }
#elif MK_CG
    a.ph_lo = 0; a.ph_hi = NPH;
    void* kargs[] = {&a};
    hipError_t e = hipLaunchCooperativeKernel((const void*)fwd_kernel, dim3(grid), dim3(512), kargs, LDS_BYTES, stream);
    if (e != hipSuccess) fprintf(stderr, "kernel_launch: cooperative launch failed: %s (grid %d)\n", hipGetErrorString(e), grid);
#else
    a.ph_lo = 0; a.ph_hi = NPH;
    if (hipMemsetAsync((char*)d_ws + WS_CTL, 0, CTL_ZERO_BYTES, stream) != hipSuccess) { fprintf(stderr, "kernel_launch: memset of the barrier words failed\n"); return; }
    hipLaunchKernelGGL(fwd_kernel, dim3(grid), dim3(512), LDS_BYTES, stream, a);
#endif
}
```
